# Optimizing an MI355X kernel written in HIP

```python
import math
import jax, jax.numpy as jnp
from jax import lax
import numpy as np

D_MODEL = 1024
BATCH = 16
SEQ = 256
DEPTH = 2
DEC_BATCH = 4
DEC_SEQ = 1024
PAST_LEN = 256

GRID_W = 64
N_HEADS = 16
HEAD_DIM = D_MODEL // N_HEADS
WIN_H = 8
WIN_W = 16
Q_BW = WIN_W
KEY_BW = 2 * WIN_W
CTX_QBLOCK = 128
D_FF = ((8 * D_MODEL // 3 + 255) // 256) * 256
N_BANDS = 16
PE_DIM = 1 + 2 * N_BANDS
FILT_W = 64
MOD_SHIFT = 0.05
DECAY_MIN = math.log(1e2) / 1.5
DECAY_MAX = math.log(1e2) / 0.3
N_HY = (DEPTH + 1) // 2
N_NA = DEPTH // 2
ALPHA = (2 * DEPTH) ** 0.25
BETA = (8 * DEPTH) ** -0.25
LN_EPS = 1e-5

kernel_name = "hyena_natten_deepnorm_dit_step"


def layer_norm(x, g, b):
    xf = x.astype(jnp.float32)
    mu = jnp.mean(xf, axis=-1, keepdims=True)
    var = jnp.mean(jnp.square(xf - mu), axis=-1, keepdims=True)
    return ((xf - mu) * lax.rsqrt(var + LN_EPS) * g + b).astype(x.dtype)


def ada_params(cvec, w, b):
    m = (jax.nn.silu(cvec) @ w + b)[:, None, :]
    return jnp.split(m, 6, axis=-1)


def centred_conv3(z, w, b):
    zp = jnp.pad(z, ((0, 0), (1, 1), (0, 0)))
    return zp[:, :-2] * w[0] + zp[:, 1:-1] * w[1] + zp[:, 2:] * w[2] + b


def hyena_filters(L, pe_w1, pe_b1, pe_w2, pe_b2, pe_w3, sin_freq, decay):
    t = jnp.linspace(0.0, 1.0, L, dtype=jnp.float32)[:, None]
    w = (2.0 * math.pi / L) * jnp.arange(L, dtype=jnp.float32)[:, None]
    bands = jnp.linspace(1e-4, N_BANDS - 1, N_BANDS, dtype=jnp.float32)[None, :]
    feats = jnp.concatenate([t, jnp.cos(bands * w), jnp.sin(bands * w)], axis=-1)
    hdn = jnp.sin(sin_freq[0] * (feats @ pe_w1 + pe_b1))
    hdn = jnp.sin(sin_freq[1] * (hdn @ pe_w2 + pe_b2))
    k = (hdn @ pe_w3).astype(jnp.float32) * (jnp.exp(-t * jnp.abs(decay)) + MOD_SHIFT)
    return k[:, :D_MODEL], k[:, D_MODEL:]


def bidir_long_conv(v, k_fwd, k_bwd, bias):
    L = v.shape[1]
    k_circ = jnp.concatenate([k_fwd, jnp.zeros((1, D_MODEL), jnp.float32), k_bwd[:0:-1]], axis=0)
    kf = jnp.fft.rfft(k_circ, axis=0)
    vf = jnp.fft.rfft(v.astype(jnp.float32), n=2 * L, axis=1)
    y = jnp.fft.irfft(vf * kf[None], n=2 * L, axis=1)[:, :L]
    return (y + v.astype(jnp.float32) * bias).astype(v.dtype)


def hyena_mixer(u, w_in, sconv_w, sconv_b, k_fwd, k_bwd, bias, w_out):
    z = centred_conv3(u @ w_in, sconv_w, sconv_b)
    x0, x1, v = jnp.split(z, 3, axis=-1)
    y = bidir_long_conv(v * x1, k_fwd, k_bwd, bias) * x0
    return y @ w_out


def split_heads(qkv):
    B, L, _ = qkv.shape
    qkv = qkv.reshape(B, L, 3, N_HEADS, HEAD_DIM).transpose(2, 0, 3, 1, 4)
    return qkv[0], qkv[1], qkv[2]


def merge_heads(o):
    B, H, L, d = o.shape
    return o.transpose(0, 2, 1, 3).reshape(B, L, H * d)


def na_context(h, w_qkv, w_out):
    B, S, _ = h.shape
    q, k, v = split_heads(h @ w_qkv)
    nb = S // CTX_QBLOCK
    qb = jnp.moveaxis(q.reshape(B, N_HEADS, nb, CTX_QBLOCK, HEAD_DIM), 2, 0) * HEAD_DIM ** -0.5

    def attend(qblk):
        s = jnp.einsum('bhqd,bhkd->bhqk', qblk, k).astype(jnp.float32)
        p = jax.nn.softmax(s, axis=-1).astype(v.dtype)
        return jnp.einsum('bhqk,bhkd->bhqd', p, v)

    o = jnp.moveaxis(lax.map(attend, qb), 0, 2).reshape(B, N_HEADS, S, HEAD_DIM)
    return merge_heads(o) @ w_out, k, v


def na_latent(h, k_ctx, v_ctx, w_qkv, rpb, w_out):
    B, L, _ = h.shape
    rows = L // GRID_W
    kh = min(WIN_H, rows)
    nj = GRID_W // Q_BW
    nk = kh * KEY_BW
    q, k, v = split_heads(h @ w_qkv)
    r = np.arange(rows)
    row0 = np.clip(r - kh // 2, 0, rows - kh)
    key_rows = row0[:, None] + np.arange(kh)[None, :]
    j = np.arange(nj)
    band0 = np.clip(j * Q_BW - WIN_W // 2, 0, GRID_W - KEY_BW)
    key_cols = band0[:, None] + np.arange(KEY_BW)[None, :]
    idx = (key_rows[:, None, :, None] * GRID_W + key_cols[None, :, None, :]).reshape(rows, nj, nk)
    kg = k[:, :, idx]
    vg = v[:, :, idx]
    qb = q.reshape(B, N_HEADS, rows, nj, Q_BW, HEAD_DIM) * HEAD_DIM ** -0.5
    q_cols = j[:, None] * Q_BW + np.arange(Q_BW)[None, :]
    win0 = np.clip(q_cols - WIN_W // 2, 0, GRID_W - WIN_W)
    kc = key_cols[:, None, :]
    col_ok = (kc >= win0[..., None]) & (kc < win0[..., None] + WIN_W)
    valid = np.broadcast_to(col_ok[:, :, None, :], (nj, Q_BW, kh, KEY_BW)).reshape(nj, Q_BW, nk)
    dr_i = (key_rows - r[:, None] + WIN_H - 1)[:, None, None, :, None]
    dc_i = np.clip(kc - q_cols[:, :, None] + WIN_W - 1, 0, 2 * WIN_W - 2)[None, :, :, None, :]
    bias = rpb[:, dr_i, dc_i].reshape(N_HEADS, rows, nj, Q_BW, nk).astype(jnp.float32)
    s_loc = jnp.einsum('bhrjqd,bhrjkd->bhrjqk', qb, kg).astype(jnp.float32) + bias[None]
    s_loc = jnp.where(valid, s_loc, -jnp.inf)
    s_ctx = jnp.einsum('bhrjqd,bhkd->bhrjqk', qb, k_ctx).astype(jnp.float32)
    p = jax.nn.softmax(jnp.concatenate([s_loc, s_ctx], axis=-1), axis=-1).astype(v.dtype)
    o = (jnp.einsum('bhrjqk,bhrjkd->bhrjqd', p[..., :nk], vg)
         + jnp.einsum('bhrjqk,bhkd->bhrjqd', p[..., nk:], v_ctx))
    o = o.reshape(B, N_HEADS, L, HEAD_DIM)
    return merge_heads(o) @ w_out


def swiglu(h, w_in, w_out):
    g, u = jnp.split(h @ w_in, 2, axis=-1)
    return (jax.nn.silu(g) * u) @ w_out


def setup_inputs(seed: int = 0) -> dict:
    key = jax.random.key(seed)
    ks = iter(jax.random.split(key, 40))
    f32 = jnp.float32

    def nrm(shape, scale):
        return jax.random.normal(next(ks), shape, f32) * scale

    D = D_MODEL
    return {
        "x_prompt": nrm((BATCH, SEQ, D), 1.0),
        "x_sample": nrm((DEC_BATCH, DEC_SEQ, D), 1.0),
        "cache_k": nrm((DEC_BATCH, N_NA, N_HEADS, PAST_LEN, HEAD_DIM), 1.0),
        "cache_v": nrm((DEC_BATCH, N_NA, N_HEADS, PAST_LEN, HEAD_DIM), 1.0),
        "c": nrm((DEC_BATCH, D), 1.0),
        "c_ctx": nrm((D,), 1.0),
        "ada_w": nrm((DEPTH, D, 6 * D), 0.5 * D ** -0.5),
        "ada_b": nrm((DEPTH, 6 * D), 0.02),
        "ln1_g": 1.0 + nrm((DEPTH, D), 0.02),
        "ln1_b": nrm((DEPTH, D), 0.02),
        "ln2_g": 1.0 + nrm((DEPTH, D), 0.02),
        "ln2_b": nrm((DEPTH, D), 0.02),
        "ffn_w_in": nrm((DEPTH, D, 2 * D_FF), D ** -0.5),
        "ffn_w_out": nrm((DEPTH, D_FF, D), BETA * D_FF ** -0.5),
        "hy_w_in": nrm((N_HY, D, 3 * D), D ** -0.5),
        "hy_sconv_w": nrm((N_HY, 3, 3 * D), 3 ** -0.5),
        "hy_sconv_b": nrm((N_HY, 3 * D), 0.02),
        "hy_pe_w1": nrm((N_HY, PE_DIM, FILT_W), PE_DIM ** -0.5),
        "hy_pe_b1": nrm((N_HY, FILT_W), 0.02),
        "hy_pe_w2": nrm((N_HY, FILT_W, FILT_W), FILT_W ** -0.5),
        "hy_pe_b2": nrm((N_HY, FILT_W), 0.02),
        "hy_pe_w3": nrm((N_HY, FILT_W, 2 * D), FILT_W ** -0.5),
        "hy_sin_freq": 1.0 + nrm((N_HY, 2, FILT_W), 0.1),
        "hy_decay": jax.random.uniform(next(ks), (N_HY, 2 * D), f32, DECAY_MIN, DECAY_MAX),
        "hy_bias": nrm((N_HY, D), 1.0),
        "hy_w_out": nrm((N_HY, D, D), BETA * D ** -0.5),
        "na_w_qkv": nrm((N_NA, D, 3 * D), D ** -0.5),
        "na_rpb": nrm((N_NA, N_HEADS, 2 * WIN_H - 1, 2 * WIN_W - 1), 0.1),
        "na_w_out": nrm((N_NA, D, D), BETA * D ** -0.5),
    }


def reference(x_prompt, x_sample, cache_k, cache_v, c, c_ctx, ada_w, ada_b, ln1_g, ln1_b, ln2_g, ln2_b,
              ffn_w_in, ffn_w_out, hy_w_in, hy_sconv_w, hy_sconv_b, hy_pe_w1, hy_pe_b1, hy_pe_w2, hy_pe_b2,
              hy_pe_w3, hy_sin_freq, hy_decay, hy_bias, hy_w_out, na_w_qkv, na_rpb, na_w_out):
    xp, xs = x_prompt, x_sample
    new_k, new_v = [], []
    for i in range(DEPTH):
        sh1_p, sc1_p, g1_p, sh2_p, sc2_p, g2_p = ada_params(c_ctx[None, :], ada_w[i], ada_b[i])
        sh1_s, sc1_s, g1_s, sh2_s, sc2_s, g2_s = ada_params(c, ada_w[i], ada_b[i])
        hp = xp * (1.0 + sc1_p) + sh1_p
        hs = xs * (1.0 + sc1_s) + sh1_s
        j = i // 2
        if i % 2 == 0:
            filt = (hy_pe_w1[j], hy_pe_b1[j], hy_pe_w2[j], hy_pe_b2[j], hy_pe_w3[j], hy_sin_freq[j], hy_decay[j])
            kf_p, kb_p = hyena_filters(xp.shape[1], *filt)
            kf_s, kb_s = hyena_filters(xs.shape[1], *filt)
            op = hyena_mixer(hp, hy_w_in[j], hy_sconv_w[j], hy_sconv_b[j], kf_p, kb_p, hy_bias[j], hy_w_out[j])
            os_ = hyena_mixer(hs, hy_w_in[j], hy_sconv_w[j], hy_sconv_b[j], kf_s, kb_s, hy_bias[j], hy_w_out[j])
        else:
            op, k_ctx, v_ctx = na_context(hp, na_w_qkv[j], na_w_out[j])
            new_k.append(k_ctx)
            new_v.append(v_ctx)
            os_ = na_latent(hs, cache_k[:, j], cache_v[:, j], na_w_qkv[j], na_rpb[j], na_w_out[j])
        xp = layer_norm(ALPHA * xp + g1_p * op, ln1_g[i], ln1_b[i])
        xs = layer_norm(ALPHA * xs + g1_s * os_, ln1_g[i], ln1_b[i])
        fp = swiglu(xp * (1.0 + sc2_p) + sh2_p, ffn_w_in[i], ffn_w_out[i])
        fs = swiglu(xs * (1.0 + sc2_s) + sh2_s, ffn_w_in[i], ffn_w_out[i])
        xp = layer_norm(ALPHA * xp + g2_p * fp, ln2_g[i], ln2_b[i])
        xs = layer_norm(ALPHA * xs + g2_s * fs, ln2_g[i], ln2_b[i])
    new_k_arr = jnp.stack(new_k, axis=1)
    new_v_arr = jnp.stack(new_v, axis=1)
    return (xp, xs, new_k_arr, new_v_arr)
```

```cpp
#include <hip/hip_runtime.h>
#include <hip/hip_cooperative_groups.h>
#include <cstdio>
#include <cstdint>
namespace cg = cooperative_groups;

#define LAS __attribute__((address_space(3)))
typedef unsigned short bf16_t;
typedef short bf16x8 __attribute__((ext_vector_type(8)));
typedef float f32x4 __attribute__((ext_vector_type(4)));
typedef float f32x16 __attribute__((ext_vector_type(16)));
typedef unsigned u32x4 __attribute__((ext_vector_type(4)));
typedef unsigned u32x2 __attribute__((ext_vector_type(2)));

#ifndef HYREP
#define HYREP 0x0u
#endif
#ifndef P0REP
#define P0REP 0x0u
#endif
constexpr int D = 1024, NTOK = 8192, NPTOK = 4096, LP = 256, LSQ = 1024, DFF = 2816, NH = 16, HD = 64;
constexpr float ALPHA_C = 1.4142135623730951f;
constexpr float LN_EPS_C = 1e-5f;
constexpr int NWAVES = 8, NTHR = 512;
constexpr int LDS_BYTES = 147456;
constexpr int HY_WSTR = 17408;
constexpr int LDS_CTL = 8 * HY_WSTR;
constexpr int HY_ZERO = LDS_CTL + 64;

constexpr size_t MB = 1024 * 1024;
constexpr size_t WS_ADA    = 0;
constexpr size_t WS_BAR    = 245760;
constexpr size_t WS_WHYIN  = 256 * 1024;
constexpr size_t WS_WHYOUT = WS_WHYIN + 6 * MB;
constexpr size_t WS_WQKV   = WS_WHYOUT + 2 * MB;
constexpr size_t WS_WNAOUT = WS_WQKV + 6 * MB;
constexpr size_t WS_WFFIN  = WS_WNAOUT + 2 * MB;
constexpr size_t WS_WFFOUT = WS_WFFIN + 22 * MB;
constexpr size_t WS_RF256  = WS_WFFOUT + 11 * MB;
constexpr size_t WS_RF1024 = WS_RF256 + 1 * MB;
constexpr size_t WS_CK     = WS_RF1024 + 4 * MB;
constexpr size_t WS_CVT    = WS_CK + 2 * MB;
constexpr size_t WS_H      = WS_CVT + 4 * MB;
constexpr size_t WS_Y      = WS_H + 16 * MB;
constexpr size_t WS_X      = WS_Y + 16 * MB;
constexpr size_t WS_P0     = WS_X + 32 * MB;
constexpr size_t WS_P1     = WS_P0 + 32 * MB;
constexpr size_t WS_BIG    = WS_P1 + 32 * MB;
constexpr size_t WS_END    = WS_BIG + 64 * MB;
constexpr int VPP = 384, VPS = 1152, CVP = 384;
constexpr size_t BQ_OFF = 0, BK_OFF = (size_t)NTOK * D, BV_OFF = 2 * (size_t)NTOK * D, BVS_OFF = BV_OFF + (size_t)16 * NH * HD * VPP;

__device__ __forceinline__ int opaque_tid() { int t = threadIdx.x; asm volatile("" : "+v"(t)); return t; }
typedef float f32x2 __attribute__((ext_vector_type(2)));
typedef __bf16 bf16x2v __attribute__((ext_vector_type(2)));
__device__ __forceinline__ unsigned cvt_pk_bf16(float lo, float hi) { const f32x2 v = {lo, hi}; const bf16x2v b = __builtin_convertvector(v, bf16x2v); return __builtin_bit_cast(unsigned, b); }
__device__ __forceinline__ bf16_t f2bf(float x) { return (bf16_t)(cvt_pk_bf16(x, 0.f) & 0xffffu); }
__device__ __forceinline__ float bf2f(bf16_t b) { return __uint_as_float(((unsigned)b) << 16); }
__device__ __forceinline__ float bflo(unsigned w) { return __uint_as_float(w << 16); }
__device__ __forceinline__ float bfhi(unsigned w) { return __uint_as_float(w & 0xffff0000u); }
__device__ __forceinline__ float silu_f(float x) { return x * __builtin_amdgcn_rcpf(1.0f + __builtin_amdgcn_exp2f(-1.4426950408889634f * x)); }
__device__ __forceinline__ float wave_sum(float v) {
#pragma unroll
    for (int o = 1; o < 64; o <<= 1) v += __shfl_xor(v, o);
    return v;
}

namespace pg8 {
constexpr int BM = 256, BK = 64, HALF = 128, HTB = HALF * BK * 2, STAGE_BYTES = 8 * HTB, NXCD = 8, WGM = 4;
__device__ __forceinline__ int lds_byte(int r, int c) { const int st = (r >> 4) * 2 + (c >> 5), rr = r & 15, cc = c & 31, ob = rr * 64 + cc * 2; return st * 1024 + (ob ^ (((ob >> 9) & 1) << 5)); }
__device__ __forceinline__ void stage_rc(int b, int& R, int& C) { const int st = b / 1024, sb = b % 1024, swz = sb ^ (((sb >> 9) & 1) << 5); R = (st >> 1) * 16 + swz / 64; C = (st & 1) * 32 + (swz % 64) / 2; }
__device__ __forceinline__ int perm32(int rho) { const int n = rho >> 4, i = rho & 15; return 8 * (i >> 2) + 4 * n + (i & 3); }

struct Unit { int pm, pn, kh; };
struct Gemm { const bf16_t* A; const bf16_t* Bt; int K; int ld; };

struct Order {
    int nM, nN, nmn, ntot, G, c;
    __device__ void init(int M, int N, int ks, int G_, int c_) { nM = M / BM; nN = N / BM; nmn = nM * nN; ntot = nmn * ks; G = G_; c = c_; }
    __device__ bool next(int i, Unit& u) const {
        const int L = i * G + c; if (L >= ntot) return false;
        u.kh = L / nmn; int wgid = L - u.kh * nmn;
        { const int q = nmn / NXCD, r = nmn % NXCD, xcd = wgid % NXCD, off = wgid / NXCD; wgid = (xcd < r ? xcd * (q + 1) : r * (q + 1) + (xcd - r) * q) + off; }
        const int nig = WGM * nN, gid = wgid / nig, fm = gid * WGM, gsz = (nM - fm) < WGM ? (nM - fm) : WGM;
        u.pm = fm + ((wgid % nig) % gsz); u.pn = (wgid % nig) / gsz; return true;
    }
};

template <class Epi>
__device__ __forceinline__ void gemm_phase(LAS unsigned char* lds, const Gemm g, const Order& S, const Epi& E) {
    const int tid = opaque_tid(), wid = __builtin_amdgcn_readfirstlane(tid >> 6), lane = tid & 63, wr = wid >> 2, wc = wid & 3, fr = lane & 15, fq = lane >> 4;
    const int K = g.ld, nt = g.K / BK;
    unsigned voffA[2], voffB[2];
#pragma unroll
    for (int i = 0; i < 2; ++i) { int R, C; stage_rc(tid * 16 + i * 8192, R, C); const int Rb = Epi::PERM ? ((R & ~31) + perm32(R & 31)) : R;
        voffA[i] = (unsigned)(R * K + C) * 2u; voffB[i] = (unsigned)(Rb * K + C) * 2u; }
    const size_t kstep = (size_t)(BK * 2);
    const size_t hstep = (size_t)HALF * K * 2;
    const size_t tstep = 2 * hstep;
    const size_t khstep = (size_t)g.K * 2;
    const unsigned ldsw = (unsigned)wid * 1024u;
    const int aoff = lds_byte(wr * 64 + fr, fq * 8), boff = lds_byte(wc * 32 + fr, fq * 8);
#define PG8_SA(b, h) (((b) * 2 + (h)) * HTB)
#define PG8_SB(b, h) ((4 + (b) * 2 + (h)) * HTB)
#define PG8_STAGE(bufoff, gbase, voff) do { _Pragma("unroll") for (int _i = 0; _i < 2; ++_i) \
        __builtin_amdgcn_global_load_lds((const unsigned*)((const char*)(gbase) + (voff)[_i]), (LAS unsigned*)(lds + (bufoff) + ldsw + _i * 8192), 16, 0, 0); } while (0)
#define PG8_LDA(dst, b, h) do { _Pragma("unroll") for (int m = 0; m < 4; ++m) _Pragma("unroll") for (int k = 0; k < 2; ++k) dst[m][k] = *(const LAS bf16x8*)(lds + PG8_SA(b, h) + aoff + m * 2048 + k * 1024); } while (0)
#define PG8_LDB(dst, b, h) do { _Pragma("unroll") for (int n = 0; n < 2; ++n) _Pragma("unroll") for (int k = 0; k < 2; ++k) dst[n][k] = *(const LAS bf16x8*)(lds + PG8_SB(b, h) + boff + n * 2048 + k * 1024); } while (0)
#define PG8_MMA(ai, bj, At, Bt) do { __builtin_amdgcn_s_setprio(1); _Pragma("unroll") for (int m = 0; m < 4; ++m) _Pragma("unroll") for (int n = 0; n < 2; ++n) _Pragma("unroll") for (int k = 0; k < 2; ++k) \
        acc[ai][bj][m][n] = __builtin_amdgcn_mfma_f32_16x16x32_bf16(Bt[n][k], At[m][k], acc[ai][bj][m][n], 0, 0, 0); __builtin_amdgcn_s_setprio(0); } while (0)
#define PG8_WAIT_V(n) asm volatile("s_waitcnt vmcnt(" #n ")" ::: "memory")
#define PG8_WAIT_L(n) asm volatile("s_waitcnt lgkmcnt(" #n ")" ::: "memory")
#define PG8_BAR __builtin_amdgcn_s_barrier()
#define PG8_SCHED __builtin_amdgcn_sched_barrier(0)
    Unit cur, nxt; int ui = 0;
    if (!S.next(0, cur)) return;
    f32x4 acc[2][2][4][2];
#pragma unroll
    for (int a = 0; a < 2; ++a)
#pragma unroll
        for (int b = 0; b < 2; ++b)
#pragma unroll
            for (int m = 0; m < 4; ++m)
#pragma unroll
                for (int n = 0; n < 2; ++n) acc[a][b][m][n] = (f32x4){0.f, 0.f, 0.f, 0.f};
    bf16x8 At[4][2], B0[2][2], B1[2][2];
    const char* cA = (const char*)g.A + (size_t)cur.pm * tstep + (size_t)cur.kh * khstep; const char* cB = (const char*)g.Bt + (size_t)cur.pn * tstep + (size_t)cur.kh * khstep;
    PG8_STAGE(PG8_SB(0, 0), cB, voffB); PG8_STAGE(PG8_SB(0, 1), cB + hstep, voffB); PG8_STAGE(PG8_SA(0, 0), cA, voffA); PG8_STAGE(PG8_SA(0, 1), cA + hstep, voffA);
    if (wr == 1) PG8_BAR;
    PG8_WAIT_V(2); PG8_BAR;
    PG8_STAGE(PG8_SB(1, 0), cB + kstep, voffB); PG8_STAGE(PG8_SA(1, 0), cA + kstep, voffA); PG8_STAGE(PG8_SB(1, 1), cB + hstep + kstep, voffB);
    PG8_WAIT_V(6); PG8_BAR;
    for (;;) {
        const bool has_next = S.next(ui + 1, nxt);
        const char* nA = has_next ? (const char*)g.A + (size_t)nxt.pm * tstep + (size_t)nxt.kh * khstep : cA; const char* nB = has_next ? (const char*)g.Bt + (size_t)nxt.pn * tstep + (size_t)nxt.kh * khstep : cB;
        for (int t = 0; t < nt; t += 2) {
            const bool last = (t == nt - 2);
            const char* a1 = cA + (size_t)(t + 1) * kstep;
            const char* a2 = last ? nA : cA + (size_t)(t + 2) * kstep; const char* b2 = last ? nB : cB + (size_t)(t + 2) * kstep;
            const char* a3 = a2 + kstep; const char* b3 = b2 + kstep;
            PG8_LDB(B0, 0, 0); PG8_LDB(B1, 0, 1); PG8_SCHED; PG8_LDA(At, 0, 0); PG8_STAGE(PG8_SA(1, 1), a1 + hstep, voffA);
            PG8_WAIT_V(8); PG8_WAIT_L(0); PG8_BAR; PG8_MMA(0, 0, At, B0); PG8_MMA(0, 1, At, B1); PG8_BAR; PG8_SCHED;
            PG8_LDA(At, 0, 1); PG8_STAGE(PG8_SB(0, 0), b2, voffB); PG8_STAGE(PG8_SB(0, 1), b2 + hstep, voffB); PG8_STAGE(PG8_SA(0, 0), a2, voffA);
            PG8_WAIT_V(8); PG8_WAIT_L(0); PG8_BAR; PG8_MMA(1, 0, At, B0); PG8_MMA(1, 1, At, B1); PG8_BAR; PG8_SCHED;
            PG8_LDB(B0, 1, 0); PG8_LDB(B1, 1, 1); PG8_SCHED; PG8_LDA(At, 1, 0); PG8_STAGE(PG8_SA(0, 1), a2 + hstep, voffA);
            PG8_WAIT_V(8); PG8_WAIT_L(0); PG8_BAR; PG8_MMA(0, 0, At, B0); PG8_MMA(0, 1, At, B1); PG8_BAR; PG8_SCHED;
            PG8_LDA(At, 1, 1); PG8_STAGE(PG8_SB(1, 0), b3, voffB); PG8_STAGE(PG8_SB(1, 1), b3 + hstep, voffB); PG8_STAGE(PG8_SA(1, 0), a3, voffA);
            PG8_WAIT_V(8); PG8_WAIT_L(0); PG8_BAR; PG8_MMA(1, 0, At, B0); PG8_MMA(1, 1, At, B1); PG8_BAR; PG8_SCHED;
        }
        if (wr == 0) PG8_BAR;
        E(acc, cur, wr, wc, fr, fq);
        if (!has_next) break;
#pragma unroll
        for (int a = 0; a < 2; ++a)
#pragma unroll
            for (int b = 0; b < 2; ++b)
#pragma unroll
                for (int m = 0; m < 4; ++m)
#pragma unroll
                    for (int n = 0; n < 2; ++n) acc[a][b][m][n] = (f32x4){0.f, 0.f, 0.f, 0.f};
        cur = nxt; cA = nA; cB = nB; ++ui;
        if (wr == 1) PG8_BAR;
    }
    PG8_WAIT_V(0);
    PG8_BAR;
#undef PG8_SA
#undef PG8_SB
#undef PG8_STAGE
#undef PG8_LDA
#undef PG8_LDB
#undef PG8_MMA
#undef PG8_WAIT_V
#undef PG8_WAIT_L
#undef PG8_BAR
#undef PG8_SCHED
}

struct EpiBf16T {
    static constexpr bool PERM = true;
    bf16_t* O; int ldc;
    __device__ __forceinline__ void operator()(const f32x4 (&acc)[2][2][4][2], const Unit& u, int wr, int wc, int fr, int fq) const {
        const int row0 = u.pm * BM + wr * 64 + fr, col0 = u.pn * BM + wc * 32 + 8 * fq;
#pragma unroll
        for (int ai = 0; ai < 2; ++ai)
#pragma unroll
            for (int m = 0; m < 4; ++m) { bf16_t* rowp = O + (size_t)(row0 + ai * HALF + m * 16) * ldc + col0;
#pragma unroll
                for (int bj = 0; bj < 2; ++bj) { const f32x4 v0 = acc[ai][bj][m][0], v1 = acc[ai][bj][m][1];
                    u32x4 w; w.x = cvt_pk_bf16(v0[0], v0[1]); w.y = cvt_pk_bf16(v0[2], v0[3]); w.z = cvt_pk_bf16(v1[0], v1[1]); w.w = cvt_pk_bf16(v1[2], v1[3]);
                    *(u32x4*)(rowp + bj * HALF) = w; } }
    }
};
template <bool BASE_F32>
struct EpiRes {
    static constexpr bool PERM = true;
    const void* bp; const void* bs;
    const float* gate;
    bf16_t* P0; bf16_t* P1;
    __device__ __forceinline__ void operator()(const f32x4 (&acc)[2][2][4][2], const Unit& u, int wr, int wc, int fr, int fq) const {
        const int row0 = u.pm * BM + wr * 64 + fr, col0 = u.pn * BM + wc * 32 + 8 * fq;
        const int v = (u.pm < 16) ? 0 : 1 + ((u.pm - 16) >> 2);
        f32x4 gv[2][2];
#pragma unroll
        for (int bj = 0; bj < 2; ++bj)
#pragma unroll
            for (int n = 0; n < 2; ++n) gv[bj][n] = *(const f32x4*)(gate + v * 6144 + col0 + bj * HALF + 4 * n);
        bf16_t* P = u.kh ? P1 : P0;
#pragma unroll
        for (int ai = 0; ai < 2; ++ai)
#pragma unroll
            for (int m = 0; m < 4; ++m) { bf16_t* rowp = P + (size_t)(row0 + ai * HALF + m * 16) * D + col0;
#pragma unroll
                for (int bj = 0; bj < 2; ++bj) { const f32x4 y0 = gv[bj][0] * acc[ai][bj][m][0], y1 = gv[bj][1] * acc[ai][bj][m][1];
                    u32x4 w; w.x = cvt_pk_bf16(y0[0], y0[1]); w.y = cvt_pk_bf16(y0[2], y0[3]); w.z = cvt_pk_bf16(y1[0], y1[1]); w.w = cvt_pk_bf16(y1[2], y1[3]);
                    *(u32x4*)(rowp + bj * HALF) = w; } }
    }
};
struct EpiSwiglu {
    static constexpr bool PERM = true;
    bf16_t* O;
    __device__ __forceinline__ void operator()(const f32x4 (&acc)[2][2][4][2], const Unit& u, int wr, int wc, int fr, int fq) const {
        const int row0 = u.pm * BM + wr * 64 + fr;
#pragma unroll
        for (int ai = 0; ai < 2; ++ai)
#pragma unroll
            for (int m = 0; m < 4; ++m) { bf16_t* rowp = O + (size_t)(row0 + ai * HALF + m * 16) * DFF + u.pn * 128 + wc * 32 + 8 * fq;
                const f32x4 a0 = acc[ai][0][m][0], a1 = acc[ai][0][m][1], b0 = acc[ai][1][m][0], b1 = acc[ai][1][m][1];
                u32x4 w; w.x = cvt_pk_bf16(silu_f(a0[0]) * b0[0], silu_f(a0[1]) * b0[1]); w.y = cvt_pk_bf16(silu_f(a0[2]) * b0[2], silu_f(a0[3]) * b0[3]);
                w.z = cvt_pk_bf16(silu_f(a1[0]) * b1[0], silu_f(a1[1]) * b1[1]); w.w = cvt_pk_bf16(silu_f(a1[2]) * b1[2], silu_f(a1[3]) * b1[3]);
                *(u32x4*)rowp = w; }
    }
};
struct EpiQKV {
    static constexpr bool PERM = true;
    bf16_t* B; float* newk; float* newv;
    __device__ __forceinline__ void operator()(const f32x4 (&acc)[2][2][4][2], const Unit& u, int wr, int wc, int fr, int fq) const {
        const int row0 = u.pm * BM + wr * 64 + fr, col0 = u.pn * BM + wc * 32 + 8 * fq;
        const bool prompt = u.pm < 16;
        if (u.pn < 4) {
#pragma unroll
            for (int ai = 0; ai < 2; ++ai)
#pragma unroll
                for (int m = 0; m < 4; ++m) { const int row = row0 + ai * HALF + m * 16; bf16_t* rowp = B + BQ_OFF + (size_t)row * D + col0;
#pragma unroll
                    for (int bj = 0; bj < 2; ++bj) { const f32x4 x0 = acc[ai][bj][m][0] * 0.125f, x1 = acc[ai][bj][m][1] * 0.125f;
                        u32x4 w; w.x = cvt_pk_bf16(x0[0], x0[1]); w.y = cvt_pk_bf16(x0[2], x0[3]); w.z = cvt_pk_bf16(x1[0], x1[1]); w.w = cvt_pk_bf16(x1[2], x1[3]);
                        *(u32x4*)(rowp + bj * HALF) = w; } }
        } else if (u.pn < 8) {
#pragma unroll
            for (int ai = 0; ai < 2; ++ai)
#pragma unroll
                for (int m = 0; m < 4; ++m) { const int row = row0 + ai * HALF + m * 16;
                    int b, s, L; size_t kb;
                    if (prompt) { b = row >> 8; s = row & 255; L = LP; kb = BK_OFF; } else { b = (row - NPTOK) >> 10; s = (row - NPTOK) & 1023; L = LSQ; kb = BK_OFF + (size_t)NPTOK * D; }
#pragma unroll
                    for (int bj = 0; bj < 2; ++bj) { const int c = col0 + bj * HALF - 1024, hh = c >> 6, dd = c & 63; const f32x4 x0 = acc[ai][bj][m][0], x1 = acc[ai][bj][m][1];
                        u32x4 w; w.x = cvt_pk_bf16(x0[0], x0[1]); w.y = cvt_pk_bf16(x0[2], x0[3]); w.z = cvt_pk_bf16(x1[0], x1[1]); w.w = cvt_pk_bf16(x1[2], x1[3]);
                        *(u32x4*)(B + kb + ((size_t)((b * NH + hh) * L + s)) * HD + dd) = w;
                        if (prompt) { float* nk = newk + ((size_t)((b * NH + hh) * LP + s)) * HD + dd; *(f32x4*)nk = x0; *(f32x4*)(nk + 4) = x1; } } }
        } else {
            const bool odd = (fr & 1) != 0;
#pragma unroll
            for (int ai = 0; ai < 2; ++ai)
#pragma unroll
                for (int m = 0; m < 4; ++m) { const int row = row0 + ai * HALF + m * 16;
                    int b, s, P; size_t vb;
                    if (prompt) { b = row >> 8; s = row & 255; P = VPP; vb = BV_OFF; } else { b = (row - NPTOK) >> 10; s = (row - NPTOK) & 1023; P = VPS; vb = BVS_OFF; }
#pragma unroll
                    for (int bj = 0; bj < 2; ++bj)
#pragma unroll
                        for (int n = 0; n < 2; ++n) { const int c = col0 + bj * HALF + 4 * n - 2048, hh = c >> 6, dd = c & 63; const f32x4 x = acc[ai][bj][m][n];
                            f32x4 y;
#pragma unroll
                            for (int e = 0; e < 4; ++e) y[e] = __shfl_xor(x[e], 1);
                            const unsigned w0 = odd ? cvt_pk_bf16(y[1], x[1]) : cvt_pk_bf16(x[0], y[0]);
                            const unsigned w1 = odd ? cvt_pk_bf16(y[3], x[3]) : cvt_pk_bf16(x[2], y[2]);
                            bf16_t* vq = B + vb + ((size_t)((b * NH + hh) * HD + dd + (odd ? 1 : 0))) * P + (s & ~1);
                            *(unsigned*)vq = w0; *(unsigned*)(vq + 2 * P) = w1;
                            if (prompt) *(f32x4*)(newv + ((size_t)((b * NH + hh) * LP + s)) * HD + dd) = x; } }
        }
    }
};
}


#define XB_TMO      128
#define XB_XCNT(j)  (256  + 64 * (j))
#define XB_XSUB(j)  (1280 + 64 * (j))
#define XB_XGEN(j)  (2304 + 64 * (j))
#define XB_TOP      3328
#define XB_TOPGEN   3392
#define XCD_BAR_WORDS 3456
#define XB_LSUB(j)  (3456 + 16 * (j))
#define XB_LGEN(j)  (3712 + 16 * (j))
#define XB_ALL_WORDS 4096
#define XB_SPIN_CAP (1u << 18)
__device__ __forceinline__ unsigned xb_ld(unsigned* p)              { return __hip_atomic_load(p, __ATOMIC_RELAXED, __HIP_MEMORY_SCOPE_AGENT); }
__device__ __forceinline__ unsigned xb_add(unsigned* p, unsigned v) { return __hip_atomic_fetch_add(p, v, __ATOMIC_RELAXED, __HIP_MEMORY_SCOPE_AGENT); }
__device__ __forceinline__ unsigned xb_xcc_id() { return (unsigned)__builtin_amdgcn_s_getreg((3 << 11) | 20) & 0xFu; }
#define XB_SPIN(cond, bar) do { unsigned _sp = 0; while (cond) { __builtin_amdgcn_s_sleep(1); \
    if ((++_sp & 255u) == 0u) { if (xb_ld(&(bar)[XB_TMO])) break; if (_sp > XB_SPIN_CAP) { atomicAdd(&(bar)[XB_TMO], 1u); break; } } } } while (0)
struct XcdBarrier { unsigned* bar; unsigned x; volatile LAS unsigned* st; };
__device__ __forceinline__ XcdBarrier xcd_barrier_post(unsigned* bar, volatile LAS unsigned* st) {
    XcdBarrier b; b.bar = bar; b.x = xb_xcc_id(); b.st = st;
    if (opaque_tid() == 0) st[3] = xb_add(&bar[XB_XCNT(b.x)], 1u);
    return b;
}
__device__ __forceinline__ void xcd_barrier_complete(unsigned* bar, unsigned x, unsigned& nloc, unsigned& nx) {
    const unsigned G = gridDim.x * gridDim.y * gridDim.z;
    unsigned sum, cnt, mine, sp = 0u;
    for (;;) {
        sum = 0u; cnt = 0u; mine = 0u;
#pragma unroll
        for (unsigned j = 0; j < 16; ++j) { const unsigned c = xb_ld(&bar[XB_XCNT(j)]); sum += c; cnt += (c > 0u) ? 1u : 0u; mine = (j == x) ? c : mine; }
        if (sum == G) break;
        __builtin_amdgcn_s_sleep(1);
        if ((++sp & 255u) == 0u) { if (xb_ld(&bar[XB_TMO])) break; if (sp > XB_SPIN_CAP) { atomicAdd(&bar[XB_TMO], 1u); break; } }
    }
    nloc = mine > 0u ? mine : 1u; nx = cnt > 0u ? cnt : 1u;
}
__device__ __forceinline__ unsigned xcd_census_uniform(unsigned* bar) {
    unsigned ok = (gridDim.x == 256u) ? 1u : 0u;
#pragma unroll
    for (unsigned j = 0; j < 16; ++j) { const unsigned c = xb_ld(&bar[XB_XCNT(j)]); if (c != (j < 8u ? 32u : 0u)) ok = 0u; }
    return ok;
}
__device__ __forceinline__ void xcd_barrier(const XcdBarrier& b) {
    asm volatile("s_waitcnt vmcnt(0)" ::: "memory");
    __syncthreads();
    if (opaque_tid() == 0) {
        unsigned* bar = b.bar;
        __builtin_amdgcn_s_waitcnt(0);
        unsigned nloc = b.st[0], nx = b.st[1];
        if (nloc == 0u) { xcd_barrier_complete(bar, b.x, nloc, nx); b.st[0] = nloc; b.st[1] = nx; b.st[2] = xcd_census_uniform(bar); }
        const unsigned old = xb_add(&bar[XB_XSUB(b.x)], 1u);
        const unsigned gen = old / nloc;
        if (old + 1u == (gen + 1u) * nloc) {
            __builtin_amdgcn_fence(__ATOMIC_RELEASE, "agent");
            asm volatile("s_waitcnt vmcnt(0)" ::: "memory");
            const unsigned og = xb_add(&bar[XB_TOP], 1u);
            const unsigned tg = og / nx;
            if (og + 1u == (tg + 1u) * nx) xb_add(&bar[XB_TOPGEN], 1u);
            else XB_SPIN(xb_ld(&bar[XB_TOPGEN]) == tg, bar);
            __builtin_amdgcn_fence(__ATOMIC_ACQUIRE, "agent");
            xb_add(&bar[XB_XGEN(b.x)], 1u);
            asm volatile("s_waitcnt vmcnt(0)" ::: "memory");
        } else {
            XB_SPIN(xb_ld(&bar[XB_XGEN(b.x)]) == gen, bar);
            __builtin_amdgcn_fence(__ATOMIC_ACQUIRE, "agent");
            asm volatile("s_waitcnt vmcnt(0)" ::: "memory");
        }
    }
    __syncthreads();
}
__device__ __forceinline__ void xcd_local_barrier(const XcdBarrier& b) {
    asm volatile("s_waitcnt vmcnt(0)" ::: "memory");
    __syncthreads();
    if (opaque_tid() == 0) {
        unsigned* bar = b.bar;
        __builtin_amdgcn_s_waitcnt(0);
        const unsigned nloc = b.st[0];
        const unsigned old = xb_add(&bar[XB_LSUB(b.x)], 1u);
        const unsigned gen = old / nloc;
        if (old + 1u == (gen + 1u) * nloc) xb_add(&bar[XB_LGEN(b.x)], 1u);
        else XB_SPIN(xb_ld(&bar[XB_LGEN(b.x)]) == gen, bar);
        __builtin_amdgcn_fence(__ATOMIC_ACQUIRE, "agent");
        asm volatile("s_waitcnt vmcnt(0)" ::: "memory");
    }
    __syncthreads();
}

struct Args { const float* in[29]; float* out; unsigned char* ws; };

__device__ __forceinline__ void transpose_item(const float* __restrict__ W, int K, int N, bf16_t* WT, int mode, LAS float* scr, int item, int lane) {
    const int nblk = N / 32, kb = item / nblk, nb = item % nblk, k0 = 64 * kb, r0 = 32 * nb;
    const int n_ = lane & 31;
    const int rho_ = r0 + n_, T_ = rho_ >> 8, w_ = rho_ & 255;
    const int srccol = (mode == 0) ? rho_ : ((w_ < 128) ? (128 * T_ + w_) : (DFF + 128 * T_ + w_ - 128));
    float tv[32];
#pragma unroll
    for (int i = 0; i < 32; ++i) { const int kk = 2 * i + (lane >> 5); tv[i] = W[(size_t)(k0 + kk) * N + srccol]; }
#pragma unroll
    for (int i = 0; i < 32; ++i) { const int kk = 2 * i + (lane >> 5); scr[kk * 33 + n_] = tv[i]; }
    asm volatile("s_waitcnt lgkmcnt(0)" ::: "memory");
    const int c = lane & 7;
#pragma unroll
    for (int j = 0; j < 4; ++j) { const int n = (lane >> 3) + 8 * j; const LAS float* s = scr + (8 * c) * 33 + n;
        u32x4 o; o.x = cvt_pk_bf16(s[0 * 33], s[1 * 33]); o.y = cvt_pk_bf16(s[2 * 33], s[3 * 33]); o.z = cvt_pk_bf16(s[4 * 33], s[5 * 33]); o.w = cvt_pk_bf16(s[6 * 33], s[7 * 33]);
        *(u32x4*)(WT + (size_t)(r0 + n) * K + k0 + 8 * c) = o; }
    asm volatile("s_waitcnt lgkmcnt(0)" ::: "memory");
}

constexpr int TI0 = 1536, TI1 = 512, TI2 = 1536, TI3 = 512, TI4 = 2816, TI6 = 1408;
constexpr int TR_P0_END = TI0 + TI1;
constexpr int TR_S2_BEG = TR_P0_END, TR_S2_END = TR_S2_BEG + TI2 + TI3;
constexpr int TR_S1_BEG = TR_S2_END, TR_S1_END = TR_S1_BEG + TI4 + TI6;
constexpr int TR_S3_BEG = TR_S1_END, TR_S3_END = TR_S3_BEG + TI4 + TI6;
__device__ __forceinline__ void transpose_dispatch(const Args& a, LAS float* scr, int r, int lane) {
    if (r < TI0) { transpose_item(a.in[14], 1024, 3072, (bf16_t*)(a.ws + WS_WHYIN), 0, scr, r, lane); return; } r -= TI0;
    if (r < TI1) { transpose_item(a.in[25], 1024, 1024, (bf16_t*)(a.ws + WS_WHYOUT), 0, scr, r, lane); return; } r -= TI1;
    if (r < TI2) { transpose_item(a.in[26], 1024, 3072, (bf16_t*)(a.ws + WS_WQKV), 0, scr, r, lane); return; } r -= TI2;
    if (r < TI3) { transpose_item(a.in[28], 1024, 1024, (bf16_t*)(a.ws + WS_WNAOUT), 0, scr, r, lane); return; } r -= TI3;
    if (r < TI4) { transpose_item(a.in[12], 1024, 5632, (bf16_t*)(a.ws + WS_WFFIN), 1, scr, r, lane); return; } r -= TI4;
    if (r < TI6) { transpose_item(a.in[13], DFF, 1024, (bf16_t*)(a.ws + WS_WFFOUT), 0, scr, r, lane); return; } r -= TI6;
    if (r < TI4) { transpose_item(a.in[12] + (size_t)1024 * 5632, 1024, 5632, (bf16_t*)(a.ws + WS_WFFIN) + (size_t)5632 * 1024, 1, scr, r, lane); return; } r -= TI4;
    transpose_item(a.in[13] + (size_t)DFF * 1024, DFF, 1024, (bf16_t*)(a.ws + WS_WFFOUT) + (size_t)1024 * DFF, 0, scr, r, lane);
}
__device__ __forceinline__ void deferred_transposes(const Args& a, LAS unsigned char* lds, int r0, int r1, int slot, int nslots) {
    const int lane = opaque_tid() & 63, wave = opaque_tid() >> 6;
    LAS float* scr = (LAS float*)(lds + wave * 16384);
    for (int r = r0 + slot * 8 + wave; r < r1; r += nslots * 8) transpose_dispatch(a, scr, r, lane);
    __syncthreads();
}

__device__ __forceinline__ void ada_item(const Args& a, LAS unsigned char* lds, int it) {
    const int tid = opaque_tid();
    const int layer = it / 96, n0 = 64 * (it % 96);
    LAS float* sl = (LAS float*)lds;
    LAS float* part = (LAS float*)(lds + 20480);
    const float* cs = a.in[4]; const float* cctx = a.in[5];
    for (int i = tid; i < 5 * 1024; i += NTHR) { const int v = i >> 10, k = i & 1023; const float x = (v == 0) ? cctx[k] : cs[(v - 1) * 1024 + k]; sl[i] = x / (1.0f + expf(-x)); }
    __syncthreads();
    const int ln = tid & 15, kg = tid >> 4;
    const float* w = a.in[6] + ((size_t)layer * 1024 + kg * 32) * 6144 + n0 + 4 * ln;
    f32x4 acc[5];
#pragma unroll
    for (int v = 0; v < 5; ++v) acc[v] = (f32x4){0.f, 0.f, 0.f, 0.f};
#pragma unroll 16
    for (int kk = 0; kk < 32; ++kk) { const f32x4 wv = *(const f32x4*)(w + (size_t)kk * 6144); const int k = kg * 32 + kk;
#pragma unroll
        for (int v = 0; v < 5; ++v) acc[v] += wv * sl[v * 1024 + k]; }
#pragma unroll
    for (int v = 0; v < 5; ++v) *(LAS f32x4*)(part + (kg * 5 + v) * 64 + 4 * ln) = acc[v];
    __syncthreads();
    if (tid < 320) { const int v = tid >> 6, n = tid & 63; float s = a.in[7][layer * 6144 + n0 + n];
        for (int g = 0; g < 32; ++g) s += part[(g * 5 + v) * 64 + n];
        __hip_atomic_store((float*)(a.ws + WS_ADA) + (layer * 5 + v) * 6144 + n0 + n, s, __ATOMIC_RELAXED, __HIP_MEMORY_SCOPE_AGENT); }
    asm volatile("s_waitcnt vmcnt(0)" ::: "memory");
    __syncthreads();
    if (tid == 0 && it < 32) (void)__hip_atomic_fetch_add((unsigned*)(a.ws + WS_BAR) + 1, 1u, __ATOMIC_RELAXED, __HIP_MEMORY_SCOPE_AGENT);
}

__device__ __forceinline__ void filter_item(const Args& a, LAS unsigned char* lds, int it) {
    const int tid = opaque_tid(), lane = tid & 63, wave = tid >> 6;
    int L, pg; bf16_t* R;
    if (it < 32) { L = 256; pg = it; R = (bf16_t*)(a.ws + WS_RF256); } else { L = 1024; pg = it - 32; R = (bf16_t*)(a.ws + WS_RF1024); }
    LAS float* H2 = (LAS float*)lds;
    LAS float* fs = (LAS float*)(lds + 4096) + wave * 128;
    const float* w1 = a.in[17]; const float* b1 = a.in[18]; const float* w2 = a.in[19]; const float* b2 = a.in[20]; const float* w3 = a.in[21];
    const float* fq = a.in[22]; const float* dec = a.in[23]; const float* hb = a.in[24];
    LAS float* w1s = (LAS float*)(lds + 8192);
    LAS float* w2s = (LAS float*)(lds + 8192 + 8448);
    { float t1[5], t2[8];
#pragma unroll
      for (int k = 0; k < 5; ++k) { const int i = tid + k * NTHR; t1[k] = (i < 33 * 64) ? w1[i] : 0.f; }
#pragma unroll
      for (int k = 0; k < 8; ++k) t2[k] = w2[tid + k * NTHR];
#pragma unroll
      for (int k = 0; k < 5; ++k) { const int i = tid + k * NTHR; if (i < 33 * 64) w1s[i] = t1[k]; }
#pragma unroll
      for (int k = 0; k < 8; ++k) w2s[tid + k * NTHR] = t2[k]; }
    __syncthreads();
    {
        const int pl = wave, pos = pg * 8 + pl;
        const float tn = (float)pos / (float)(L - 1);
        const float wang = (6.283185307179586f / (float)L) * (float)pos;
        if (lane < 33) { float f;
            if (lane == 0) f = tn;
            else { const int kb = (lane - 1) & 15; const float band = 1e-4f + (float)kb * ((15.0f - 1e-4f) / 15.0f); const float arg = band * wang; f = (lane <= 16) ? cosf(arg) : sinf(arg); }
            fs[lane] = f; }
        asm volatile("s_waitcnt lgkmcnt(0)" ::: "memory");
        float s = b1[lane];
#pragma unroll 11
        for (int e = 0; e < 33; ++e) s += fs[e] * w1s[e * 64 + lane];
        fs[64 + lane] = sinf(fq[lane] * s);
        asm volatile("s_waitcnt lgkmcnt(0)" ::: "memory");
        float s2 = b2[lane];
#pragma unroll 16
        for (int e = 0; e < 64; ++e) s2 += fs[64 + e] * w2s[e * 64 + lane];
        H2[pl * 64 + lane] = sinf(fq[64 + lane] * s2);
        asm volatile("s_waitcnt lgkmcnt(0)" ::: "memory");
    }
    __syncthreads();
    const f32x4 dc = *(const f32x4*)(dec + 4 * tid);
    {
        f32x4 acc[8];
#pragma unroll
        for (int p = 0; p < 8; ++p) acc[p] = (f32x4){0.f, 0.f, 0.f, 0.f};
#pragma unroll 16
        for (int e = 0; e < 64; ++e) { const f32x4 wv = *(const f32x4*)(w3 + (size_t)e * 2048 + 4 * tid);
#pragma unroll
            for (int p = 0; p < 8; ++p) acc[p] += wv * H2[p * 64 + e]; }
#pragma unroll
        for (int cc = 0; cc < 4; ++cc) { const int c = 4 * tid + cc; const float ad = fabsf(dc[cc]);
            float v8[8];
#pragma unroll
            for (int p = 0; p < 8; ++p) { const float tn = (float)(pg * 8 + p) / (float)(L - 1); v8[p] = acc[p][cc] * (__expf(-tn * ad) + 0.05f); }
            if (c < D) {
                if (pg == 0) v8[0] += hb[c];
                u32x4 w; w.x = cvt_pk_bf16(v8[7], v8[6]); w.y = cvt_pk_bf16(v8[5], v8[4]); w.z = cvt_pk_bf16(v8[3], v8[2]); w.w = cvt_pk_bf16(v8[1], v8[0]);
                *(u32x4*)(R + (size_t)c * 2 * L + L - 8 * (pg + 1)) = w;
            } else {
                bf16_t* row = R + (size_t)(c - D) * 2 * L; const int m0 = L - 1 + 8 * pg;
                if (pg == 0) row[2 * L - 1] = 0; else row[m0] = f2bf(v8[0]);
                *(unsigned*)(row + m0 + 1) = cvt_pk_bf16(v8[1], v8[2]); *(unsigned*)(row + m0 + 3) = cvt_pk_bf16(v8[3], v8[4]); *(unsigned*)(row + m0 + 5) = cvt_pk_bf16(v8[5], v8[6]);
                row[m0 + 7] = f2bf(v8[7]);
            }
        }
    }
    __syncthreads();
}

__device__ __forceinline__ void e1_item(const Args& a, int e) {
    const int tid = opaque_tid(), lane = tid & 63, wave = tid >> 6;
    if (tid == 0) { unsigned* done = (unsigned*)(a.ws + WS_BAR) + 1; unsigned sp = 0u;
        while (__hip_atomic_load(done, __ATOMIC_RELAXED, __HIP_MEMORY_SCOPE_AGENT) < 32u) { __builtin_amdgcn_s_sleep(2); if (++sp > (1u << 20)) break; }
        __builtin_amdgcn_fence(__ATOMIC_ACQUIRE, "agent");
        asm volatile("s_waitcnt vmcnt(0)" ::: "memory"); }
    __syncthreads();
    const float* ada = (const float*)(a.ws + WS_ADA);
    bf16_t* H = (bf16_t*)(a.ws + WS_H);
#pragma unroll
    for (int i = 0; i < 4; ++i) { const int row = 32 * e + 4 * wave + i;
        const float* src = (row < NPTOK) ? a.in[0] + (size_t)row * D : a.in[1] + (size_t)(row - NPTOK) * D;
        const int v = (row < NPTOK) ? 0 : 1 + ((row - NPTOK) >> 10);
        const float* av = ada + v * 6144;
#pragma unroll
        for (int j = 0; j < 4; ++j) { const int col = 4 * lane + 256 * j;
            const f32x4 x = *(const f32x4*)(src + col), sh = *(const f32x4*)(av + col), sc = *(const f32x4*)(av + 1024 + col);
            const f32x4 y = x * (sc + 1.0f) + sh; u32x2 w; w.x = cvt_pk_bf16(y[0], y[1]); w.y = cvt_pk_bf16(y[2], y[3]);
            *(u32x2*)(H + (size_t)row * D + col) = w; } }
}

__device__ __forceinline__ void p0_prep(const Args& a, LAS unsigned char* lds) {
    const int tid = opaque_tid(), lane = tid & 63, wave = tid >> 6, bx = blockIdx.x, G = gridDim.x;
    LAS float* scr = (LAS float*)(lds + wave * 16384);
    constexpr int NIT = TR_P0_END, NCHUNK = NIT / 8, NE1 = NTOK / 32, NFILT = 160, NPRE = NFILT + 192, NITEMS = NPRE + NCHUNK + NE1;
    static_assert(NIT % 8 == 0, "transpose items in chunks of 8");
    unsigned* ctr = (unsigned*)(a.ws + WS_BAR);
    volatile LAS int* nxt = (volatile LAS int*)(lds + LDS_CTL + 128);
    for (;;) {
        __syncthreads();
        if (tid == 0) *nxt = (int)__hip_atomic_fetch_add(ctr, 1u, __ATOMIC_RELAXED, __HIP_MEMORY_SCOPE_AGENT);
        __syncthreads();
        const int item = *nxt;
        if (item >= NITEMS) break;
        if (item < NFILT) { filter_item(a, lds, item); continue; }
        if (item < NPRE) { ada_item(a, lds, item - NFILT); continue; }
        if (item >= NPRE + NCHUNK) { e1_item(a, item - NPRE - NCHUNK); continue; }
        transpose_dispatch(a, scr, (item - NPRE) * 8 + wave, lane);
    }
    __syncthreads();
}

__device__ __forceinline__ void e1_modulate(const Args& a) {
    const int lane = opaque_tid() & 63, gw = blockIdx.x * NWAVES + (opaque_tid() >> 6), NGW = gridDim.x * NWAVES;
    const float* ada = (const float*)(a.ws + WS_ADA);
    bf16_t* H = (bf16_t*)(a.ws + WS_H);
    for (int row = gw; row < NTOK; row += NGW) {
        const float* src = (row < NPTOK) ? a.in[0] + (size_t)row * D : a.in[1] + (size_t)(row - NPTOK) * D;
        const int v = (row < NPTOK) ? 0 : 1 + ((row - NPTOK) >> 10);
        const float* av = ada + v * 6144;
#pragma unroll
        for (int j = 0; j < 4; ++j) { const int col = 4 * lane + 256 * j;
            const f32x4 x = *(const f32x4*)(src + col), sh = *(const f32x4*)(av + col), sc = *(const f32x4*)(av + 1024 + col);
            const f32x4 y = x * (sc + 1.0f) + sh; u32x2 w; w.x = cvt_pk_bf16(y[0], y[1]); w.y = cvt_pk_bf16(y[2], y[3]);
            *(u32x2*)(H + (size_t)row * D + col) = w; }
    }
}
template <bool FINAL> __device__ __forceinline__ void ln_rows4(const Args& a, const float* lng, const float* lnb, float* xout, const float* adav, int rowbase, const float* bpf, const float* bsf);
template <bool FINAL>
__device__ __forceinline__ void ln_phase(const Args& a, const float* lng, const float* lnb, float* xout, const float* adav  , int vb = -1, const float* bpf = nullptr, const float* bsf = nullptr) {
    if (vb >= 0) { ln_rows4<FINAL>(a, lng, lnb, xout, adav, 1024 * (vb & 7) + 32 * (vb >> 3) + 4 * (opaque_tid() >> 6), bpf, bsf); return; }
    const int lane = opaque_tid() & 63, wv = opaque_tid() >> 6;
    const int gw = (vb >= 0) ? (1024 * (vb & 7) + 32 * (vb >> 3) + 4 * wv) : (int)(blockIdx.x * NWAVES + wv), NGW = (vb >= 0) ? 1 : (int)(gridDim.x * NWAVES);
    const int rend = (vb >= 0) ? gw + 4 : NTOK;
    const bf16_t* P0 = (const bf16_t*)(a.ws + WS_P0); const bf16_t* P1 = (const bf16_t*)(a.ws + WS_P1);
    bf16_t* H = (bf16_t*)(a.ws + WS_H); bf16_t* X = (bf16_t*)(a.ws + WS_X);
    for (int row = gw; row < rend; row += NGW) {
        float v[16]; float s = 0.f;
#pragma unroll
        for (int j = 0; j < 2; ++j) { const int col = 8 * lane + 512 * j;
            const u32x4 p = *(const u32x4*)(P0 + (size_t)row * D + col), q = *(const u32x4*)(P1 + (size_t)row * D + col);
            v[8 * j + 0] = bflo(p.x) + bflo(q.x); v[8 * j + 1] = bfhi(p.x) + bfhi(q.x); v[8 * j + 2] = bflo(p.y) + bflo(q.y); v[8 * j + 3] = bfhi(p.y) + bfhi(q.y);
            v[8 * j + 4] = bflo(p.z) + bflo(q.z); v[8 * j + 5] = bfhi(p.z) + bfhi(q.z); v[8 * j + 6] = bflo(p.w) + bflo(q.w); v[8 * j + 7] = bfhi(p.w) + bfhi(q.w);
            if (bpf) { const float* br = ((row < NPTOK) ? bpf + (size_t)row * D : bsf + (size_t)(row - NPTOK) * D) + col; const f32x4 b0 = *(const f32x4*)br, b1 = *(const f32x4*)(br + 4);
#pragma unroll
                for (int e = 0; e < 4; ++e) { v[8 * j + e] += ALPHA_C * b0[e]; v[8 * j + 4 + e] += ALPHA_C * b1[e]; } }
            else { const u32x4 xb = *(const u32x4*)((const bf16_t*)(a.ws + WS_X) + (size_t)row * D + col);
                v[8 * j + 0] += ALPHA_C * bflo(xb.x); v[8 * j + 1] += ALPHA_C * bfhi(xb.x); v[8 * j + 2] += ALPHA_C * bflo(xb.y); v[8 * j + 3] += ALPHA_C * bfhi(xb.y);
                v[8 * j + 4] += ALPHA_C * bflo(xb.z); v[8 * j + 5] += ALPHA_C * bfhi(xb.z); v[8 * j + 6] += ALPHA_C * bflo(xb.w); v[8 * j + 7] += ALPHA_C * bfhi(xb.w); } }
#pragma unroll
        for (int e = 0; e < 16; ++e) s += v[e];
        const float mean = wave_sum(s) * (1.0f / D); float s2 = 0.f;
#pragma unroll
        for (int e = 0; e < 16; ++e) { v[e] -= mean; s2 += v[e] * v[e]; }
        const float rstd = 1.0f / sqrtf(wave_sum(s2) * (1.0f / D) + LN_EPS_C);
        const int vi = (row < NPTOK) ? 0 : 1 + ((row - NPTOK) >> 10);
#pragma unroll
        for (int j = 0; j < 2; ++j) { const int col = 8 * lane + 512 * j;
            const f32x4 g0 = *(const f32x4*)(lng + col), g1 = *(const f32x4*)(lng + col + 4), b0 = *(const f32x4*)(lnb + col), b1 = *(const f32x4*)(lnb + col + 4);
            f32x4 y0, y1;
#pragma unroll
            for (int e = 0; e < 4; ++e) { y0[e] = v[8 * j + e] * rstd * g0[e] + b0[e]; y1[e] = v[8 * j + 4 + e] * rstd * g1[e] + b1[e]; }
            if (FINAL) { *(f32x4*)(xout + (size_t)row * D + col) = y0; *(f32x4*)(xout + (size_t)row * D + col + 4) = y1; }
            else {
                u32x4 w; w.x = cvt_pk_bf16(y0[0], y0[1]); w.y = cvt_pk_bf16(y0[2], y0[3]); w.z = cvt_pk_bf16(y1[0], y1[1]); w.w = cvt_pk_bf16(y1[2], y1[3]);
                *(u32x4*)(X + (size_t)row * D + col) = w;
                const float* ap = adav + vi * 6144 + col;
                const f32x4 sh0 = *(const f32x4*)(ap), sh1 = *(const f32x4*)(ap + 4), sc0 = *(const f32x4*)(ap + 1024), sc1 = *(const f32x4*)(ap + 1028);
                const f32x4 h0 = y0 * (sc0 + 1.0f) + sh0, h1 = y1 * (sc1 + 1.0f) + sh1;
                u32x4 hw; hw.x = cvt_pk_bf16(h0[0], h0[1]); hw.y = cvt_pk_bf16(h0[2], h0[3]); hw.z = cvt_pk_bf16(h1[0], h1[1]); hw.w = cvt_pk_bf16(h1[2], h1[3]);
                *(u32x4*)(H + (size_t)row * D + col) = hw; }
        }
    }
}


template <bool FINAL>
__device__ __forceinline__ void ln_rows4(const Args& a, const float* lng, const float* lnb, float* xout, const float* adav, int rowbase, const float* bpf, const float* bsf) {
    const int lane = opaque_tid() & 63;
    const bf16_t* P0 = (const bf16_t*)(a.ws + WS_P0); const bf16_t* P1 = (const bf16_t*)(a.ws + WS_P1);
    bf16_t* H = (bf16_t*)(a.ws + WS_H); bf16_t* X = (bf16_t*)(a.ws + WS_X);
    constexpr int RB = 4;
    float v[RB][16]; float mean[RB], rstd[RB];
#pragma unroll
    for (int rr = 0; rr < RB; ++rr) { const int row = rowbase + rr;
#pragma unroll
        for (int j = 0; j < 2; ++j) { const int col = 8 * lane + 512 * j;
            const u32x4 p = *(const u32x4*)(P0 + (size_t)row * D + col), q = *(const u32x4*)(P1 + (size_t)row * D + col);
            v[rr][8 * j + 0] = bflo(p.x) + bflo(q.x); v[rr][8 * j + 1] = bfhi(p.x) + bfhi(q.x); v[rr][8 * j + 2] = bflo(p.y) + bflo(q.y); v[rr][8 * j + 3] = bfhi(p.y) + bfhi(q.y);
            v[rr][8 * j + 4] = bflo(p.z) + bflo(q.z); v[rr][8 * j + 5] = bfhi(p.z) + bfhi(q.z); v[rr][8 * j + 6] = bflo(p.w) + bflo(q.w); v[rr][8 * j + 7] = bfhi(p.w) + bfhi(q.w);
            if (bpf) { const float* br = ((row < NPTOK) ? bpf + (size_t)row * D : bsf + (size_t)(row - NPTOK) * D) + col; const f32x4 b0 = *(const f32x4*)br, b1 = *(const f32x4*)(br + 4);
#pragma unroll
                for (int e = 0; e < 4; ++e) { v[rr][8 * j + e] += ALPHA_C * b0[e]; v[rr][8 * j + 4 + e] += ALPHA_C * b1[e]; } }
            else { const u32x4 xb = *(const u32x4*)(X + (size_t)row * D + col);
                v[rr][8 * j + 0] += ALPHA_C * bflo(xb.x); v[rr][8 * j + 1] += ALPHA_C * bfhi(xb.x); v[rr][8 * j + 2] += ALPHA_C * bflo(xb.y); v[rr][8 * j + 3] += ALPHA_C * bfhi(xb.y);
                v[rr][8 * j + 4] += ALPHA_C * bflo(xb.z); v[rr][8 * j + 5] += ALPHA_C * bfhi(xb.z); v[rr][8 * j + 6] += ALPHA_C * bflo(xb.w); v[rr][8 * j + 7] += ALPHA_C * bfhi(xb.w); } } }
#pragma unroll
    for (int rr = 0; rr < RB; ++rr) { float s = 0.f;
#pragma unroll
        for (int e = 0; e < 16; ++e) s += v[rr][e];
        mean[rr] = s; }
#pragma unroll
    for (int o = 1; o < 64; o <<= 1)
#pragma unroll
        for (int rr = 0; rr < RB; ++rr) mean[rr] += __shfl_xor(mean[rr], o);
#pragma unroll
    for (int rr = 0; rr < RB; ++rr) { mean[rr] *= (1.0f / D); float s2 = 0.f;
#pragma unroll
        for (int e = 0; e < 16; ++e) { v[rr][e] -= mean[rr]; s2 += v[rr][e] * v[rr][e]; }
        rstd[rr] = s2; }
#pragma unroll
    for (int o = 1; o < 64; o <<= 1)
#pragma unroll
        for (int rr = 0; rr < RB; ++rr) rstd[rr] += __shfl_xor(rstd[rr], o);
    const int vi = (rowbase < NPTOK) ? 0 : 1 + ((rowbase - NPTOK) >> 10);
#pragma unroll
    for (int rr = 0; rr < RB; ++rr) { const int row = rowbase + rr;
        const float rs = 1.0f / sqrtf(rstd[rr] * (1.0f / D) + LN_EPS_C);
#pragma unroll
        for (int j = 0; j < 2; ++j) { const int col = 8 * lane + 512 * j;
            const f32x4 g0 = *(const f32x4*)(lng + col), g1 = *(const f32x4*)(lng + col + 4), b0 = *(const f32x4*)(lnb + col), b1 = *(const f32x4*)(lnb + col + 4);
            f32x4 y0, y1;
#pragma unroll
            for (int e = 0; e < 4; ++e) { y0[e] = v[rr][8 * j + e] * rs * g0[e] + b0[e]; y1[e] = v[rr][8 * j + 4 + e] * rs * g1[e] + b1[e]; }
            if (FINAL) { *(f32x4*)(xout + (size_t)row * D + col) = y0; *(f32x4*)(xout + (size_t)row * D + col + 4) = y1; }
            else {
                u32x4 w; w.x = cvt_pk_bf16(y0[0], y0[1]); w.y = cvt_pk_bf16(y0[2], y0[3]); w.z = cvt_pk_bf16(y1[0], y1[1]); w.w = cvt_pk_bf16(y1[2], y1[3]);
                *(u32x4*)(X + (size_t)row * D + col) = w;
                const float* ap = adav + vi * 6144 + col;
                const f32x4 sh0 = *(const f32x4*)(ap), sh1 = *(const f32x4*)(ap + 4), sc0 = *(const f32x4*)(ap + 1024), sc1 = *(const f32x4*)(ap + 1028);
                const f32x4 h0 = y0 * (sc0 + 1.0f) + sh0, h1 = y1 * (sc1 + 1.0f) + sh1;
                u32x4 hw; hw.x = cvt_pk_bf16(h0[0], h0[1]); hw.y = cvt_pk_bf16(h0[2], h0[3]); hw.z = cvt_pk_bf16(h1[0], h1[1]); hw.w = cvt_pk_bf16(h1[2], h1[3]);
                *(u32x4*)(H + (size_t)row * D + col) = hw; }
        }
    }
}

__device__ __forceinline__ void conv3_chunk(const bf16_t* zrow, int s0, int L, float w0, float w1, float w2, float bb, float (&o)[8]) {
    const u32x4 q = *(const u32x4*)(zrow + s0);
    float z[10];
    z[1] = bflo(q.x); z[2] = bfhi(q.x); z[3] = bflo(q.y); z[4] = bfhi(q.y); z[5] = bflo(q.z); z[6] = bfhi(q.z); z[7] = bflo(q.w); z[8] = bfhi(q.w);
    z[0] = (s0 > 0) ? bf2f(zrow[s0 - 1]) : 0.f; z[9] = (s0 + 8 < L) ? bf2f(zrow[s0 + 8]) : 0.f;
#pragma unroll
    for (int e = 0; e < 8; ++e) o[e] = z[e] * w0 + z[e + 1] * w1 + z[e + 2] * w2 + bb;
}
__device__ __forceinline__ void conv3_regs(const u32x4 q, bf16_t prev, bf16_t next, float w0, float w1, float w2, float bb, float (&o)[8]) {
    float z[10];
    z[0] = bf2f(prev); z[1] = bflo(q.x); z[2] = bfhi(q.x); z[3] = bflo(q.y); z[4] = bfhi(q.y); z[5] = bflo(q.z); z[6] = bfhi(q.z); z[7] = bflo(q.w); z[8] = bfhi(q.w); z[9] = bf2f(next);
#pragma unroll
    for (int e = 0; e < 8; ++e) o[e] = z[e] * w0 + z[e + 1] * w1 + z[e + 2] * w2 + bb;
}
template <int L, int NBH>
__device__ __forceinline__ void hyena_item(const Args& a, LAS unsigned char* lds, int d0, int tokbase) {
    constexpr int nA = L / 32, BPT = 32 / nA, NT = NBH * nA / 32, NTOKI = NBH * L;
    static_assert(NT == 2 && NTOKI == 2048, "half-item geometry");
    const int tid = opaque_tid(), lane = tid & 63, wave = tid >> 6;
    const int d = d0 + wave;
    const bf16_t* zT = (const bf16_t*)(a.ws + WS_BIG);
    const bf16_t* R = (const bf16_t*)(a.ws + (L == 256 ? WS_RF256 : WS_RF1024)) + (size_t)d * 2 * L;
    LAS unsigned char* Fr = lds + wave * HY_WSTR;
    LAS unsigned char* Vr = Fr + 8192;
    LAS unsigned* cp = (LAS unsigned*)Fr;
    const float* sw = a.in[15]; const float* sb = a.in[16];
    LAS unsigned char* Xr = Fr + 13312;
    for (int hr1_ = 0; hr1_ <= (int)(HYREP & 1u); ++hr1_) {
    { const u32x4* rd4 = (const u32x4*)R; const unsigned* rd = (const unsigned*)R;
      u32x4 fx[L / 256]; unsigned fy[L / 256];
#pragma unroll
      for (int it = 0; it < L / 256; ++it) { const int q4 = lane + 64 * it; fx[it] = rd4[q4]; fy[it] = (4 * q4 + 4 < L) ? rd[4 * q4 + 4] : 0u; }
#pragma unroll
      for (int it = 0; it < L / 256; ++it) { const int q = 4 * (lane + 64 * it); const u32x4 x = fx[it];
          *(LAS u32x4*)(cp + q) = x;
          u32x4 y; y.x = (x.x >> 16) | (x.y << 16); y.y = (x.y >> 16) | (x.z << 16); y.z = (x.z >> 16) | (x.w << 16); y.w = (x.w >> 16) | (fy[it] << 16);
          *(LAS u32x4*)(cp + L + q) = y; } }
    { const float v0 = sw[2048 + d], v1 = sw[3072 + 2048 + d], v2 = sw[6144 + 2048 + d], vb = sb[2048 + d];
      const float x0 = sw[1024 + d], x1 = sw[3072 + 1024 + d], x2 = sw[6144 + 1024 + d], xb = sb[1024 + d];
      const float o0 = sw[d], o1 = sw[3072 + d], o2 = sw[6144 + d], ob = sb[d];
      const bf16_t* zv = zT + (size_t)(2048 + d) * NTOK + tokbase; const bf16_t* zx = zT + (size_t)(1024 + d) * NTOK + tokbase; const bf16_t* zo = zT + (size_t)d * NTOK + tokbase;
      constexpr int NI = NTOKI / 8 / 64;
      u32x4 rv[NI], rx[NI], ro[NI]; bf16_t pv[NI], nv[NI], px[NI], nx[NI], po[NI], no[NI];
#pragma unroll
      for (int it = 0; it < NI; ++it) { const int idx = lane + 64 * it; const int t0 = idx * 8, s0 = t0 % L;
          rv[it] = *(const u32x4*)(zv + t0); rx[it] = *(const u32x4*)(zx + t0); ro[it] = *(const u32x4*)(zo + t0);
          const bool hp = s0 > 0, hn = s0 + 8 < L;
          pv[it] = hp ? zv[t0 - 1] : (bf16_t)0; nv[it] = hn ? zv[t0 + 8] : (bf16_t)0;
          px[it] = hp ? zx[t0 - 1] : (bf16_t)0; nx[it] = hn ? zx[t0 + 8] : (bf16_t)0;
          po[it] = hp ? zo[t0 - 1] : (bf16_t)0; no[it] = hn ? zo[t0 + 8] : (bf16_t)0; }
#pragma unroll
      for (int it = 0; it < NI; ++it) { const int idx = lane + 64 * it; const int t0 = idx * 8;
          float cv[8], cx[8], co[8];
          conv3_regs(rv[it], pv[it], nv[it], v0, v1, v2, vb, cv); conv3_regs(rx[it], px[it], nx[it], x0, x1, x2, xb, cx); conv3_regs(ro[it], po[it], no[it], o0, o1, o2, ob, co);
          u32x4 w; w.x = cvt_pk_bf16(cv[0] * cx[0], cv[1] * cx[1]); w.y = cvt_pk_bf16(cv[2] * cx[2], cv[3] * cx[3]); w.z = cvt_pk_bf16(cv[4] * cx[4], cv[5] * cx[5]); w.w = cvt_pk_bf16(cv[6] * cx[6], cv[7] * cx[7]);
          *(LAS u32x4*)(Vr + (t0 >> 5) * 80 + (t0 & 31) * 2) = w;
          u32x4 wo; wo.x = cvt_pk_bf16(co[0], co[1]); wo.y = cvt_pk_bf16(co[2], co[3]); wo.z = cvt_pk_bf16(co[4], co[5]); wo.w = cvt_pk_bf16(co[6], co[7]);
          *(LAS u32x4*)(Xr + (size_t)t0 * 2) = wo; } }
    __syncthreads(); }
    __syncthreads();
    f32x16 acc[NT];
#pragma unroll
    for (int q = 0; q < NT; ++q)
#pragma unroll
        for (int e = 0; e < 16; ++e) acc[q][e] = 0.f;
    for (int hr2_ = 0; hr2_ <= (int)((HYREP >> 1) & 1u); ++hr2_) {
    if (hr2_ == 1) { _Pragma("unroll") for (int q = 0; q < NT; ++q) _Pragma("unroll") for (int e = 0; e < 16; ++e) acc[q][e] *= 0.5f; }
    {
        const int i = lane & 31, h = lane >> 5, p = 1 - (i & 1);
        const int n = lane & 31, aidx = n % nA, bsub = n / nA;
        LAS const unsigned* cpp = cp + p * L;
        LAS const unsigned char* zero16 = lds + HY_ZERO;
        LAS const unsigned char* vlane = Vr + bsub * nA * 80 + 16 * h;
        const int mbase = (L - 1) - i + 8 * h;
        LAS const unsigned* ap = cpp + (mbase >> 1) + 16 * (nA - 1);
        int ab = aidx + (nA - 1);
        LAS const unsigned char* vr = vlane + ab * 80;
#pragma unroll 1
        for (int it = 0; it < 2 * nA - 1; ++it) {
            const bool ok = (ab >= 0) && (ab < nA);
            LAS const unsigned char* vrow = ok ? vr : zero16;
            const int vstep = ok ? BPT * nA * 80 : 0, jstep = ok ? 32 : 0;
            u32x4 af0, af1; af0.x = ap[0]; af0.y = ap[1]; af0.z = ap[2]; af0.w = ap[3]; af1.x = ap[8]; af1.y = ap[9]; af1.z = ap[10]; af1.w = ap[11];
            u32x4 bf[NT][2];
#pragma unroll
            for (int q = 0; q < NT; ++q) { bf[q][0] = *(LAS const u32x4*)(vrow + q * vstep); bf[q][1] = *(LAS const u32x4*)(vrow + q * vstep + jstep); }
#pragma unroll
            for (int q = 0; q < NT; ++q) {
                acc[q] = __builtin_amdgcn_mfma_f32_32x32x16_bf16(__builtin_bit_cast(bf16x8, af0), __builtin_bit_cast(bf16x8, bf[q][0]), acc[q], 0, 0, 0);
                acc[q] = __builtin_amdgcn_mfma_f32_32x32x16_bf16(__builtin_bit_cast(bf16x8, af1), __builtin_bit_cast(bf16x8, bf[q][1]), acc[q], 0, 0, 0); }
            ap -= 16; ab -= 1; vr -= 80;
        }
    }
    }
    if ((HYREP >> 1) & 1u) { _Pragma("unroll") for (int q = 0; q < NT; ++q) _Pragma("unroll") for (int e = 0; e < 16; ++e) acc[q][e] *= (2.0f / 3.0f); }
    __syncthreads();
    { const int h = lane >> 5, n = lane & 31, aidx = n % nA, bsub = n / nA;
#pragma unroll
      for (int q = 0; q < NT; ++q) { const int b = q * BPT + bsub;
#pragma unroll
          for (int rg = 0; rg < 4; ++rg) { const int t = 32 * aidx + 8 * rg + 4 * h; const int off = (b * L + t) * 2;
              const u32x2 xc = *(LAS const u32x2*)(Xr + off);
              u32x2 w; w.x = cvt_pk_bf16(acc[q][4 * rg] * bflo(xc.x), acc[q][4 * rg + 1] * bfhi(xc.x)); w.y = cvt_pk_bf16(acc[q][4 * rg + 2] * bflo(xc.y), acc[q][4 * rg + 3] * bfhi(xc.y));
              *(LAS u32x2*)(Vr + ((b * L + t) >> 5) * 80 + (t & 31) * 2) = w; } } }
    __syncthreads();
    for (int hr3_ = 0; hr3_ <= (int)((HYREP >> 2) & 1u); ++hr3_)
    { bf16_t* Y = (bf16_t*)(a.ws + WS_Y);
#pragma unroll
      for (int it = 0; it < NTOKI / NTHR; ++it) { const int tok = tid + it * NTHR; unsigned short e[8];
#pragma unroll
          for (int w = 0; w < 8; ++w) e[w] = *(LAS const unsigned short*)(lds + w * HY_WSTR + 8192 + (tok >> 5) * 80 + (tok & 31) * 2);
          u32x4 o; o.x = e[0] | ((unsigned)e[1] << 16); o.y = e[2] | ((unsigned)e[3] << 16); o.z = e[4] | ((unsigned)e[5] << 16); o.w = e[6] | ((unsigned)e[7] << 16);
          *(u32x4*)(Y + (size_t)(tokbase + tok) * D + d0) = o; } }
    __syncthreads();
}

constexpr int AT_KP = 144, AT_VP = 528;
constexpr int AT_K_OFF = 2048, AT_V_OFF = AT_K_OFF + 256 * AT_KP;
constexpr int AT_LVP = 912;
constexpr int AT_LK_OFF = 2048, AT_LV_OFF = 65536;
__device__ __forceinline__ void attn_stage_kv(LAS unsigned char* lds, const char* ksrc, const char* vsrc, int vpitch) {
    const int tid = opaque_tid();
    u32x4 kv[4], vv[4];
#pragma unroll
    for (int k = 0; k < 4; ++k) { const int p = tid + NTHR * k; kv[k] = *(const u32x4*)(ksrc + (size_t)p * 16); vv[k] = *(const u32x4*)(vsrc + (size_t)(p >> 5) * vpitch + (p & 31) * 16); }
#pragma unroll
    for (int k = 0; k < 4; ++k) { const int p = tid + NTHR * k;
        *(LAS u32x4*)(lds + AT_K_OFF + (p >> 3) * AT_KP + (p & 7) * 16) = kv[k];
        *(LAS u32x4*)(lds + AT_V_OFF + (p >> 5) * AT_VP + (p & 31) * 16) = vv[k]; }
}
template <bool FROM_LDS, bool MASK>
__device__ __forceinline__ void attn_chunk(f32x4 (&O)[4], float& m_run, float& sum, const bf16x8 q0, const bf16x8 q1,
                                           const char* kb, const char* vb, int kseg, int vseg, int vrow16, unsigned k0o, unsigned k1o, unsigned vo,
                                           LAS const unsigned char* lk, LAS const unsigned char* lv,
                                           LAS const float* rb, int band0, int g, int qc, int win0) {
    f32x4 S[4][2];
    bf16x8 Vf[4][4];
#pragma unroll
    for (int s4 = 0; s4 < 2; ++s4)
#pragma unroll
        for (int db = 0; db < 4; ++db) {
            if (!FROM_LDS) Vf[s4][db] = *(const bf16x8*)(vb + (size_t)s4 * vseg + (size_t)db * vrow16 + vo); }
#pragma unroll
    for (int s4 = 0; s4 < 4; ++s4) {
        bf16x8 a00, a01, a10, a11;
        if (FROM_LDS) { LAS const unsigned char* ks = lk + s4 * kseg;
            a00 = *(LAS const bf16x8*)(ks); a01 = *(LAS const bf16x8*)(ks + 64); a10 = *(LAS const bf16x8*)(ks + 4 * AT_KP); a11 = *(LAS const bf16x8*)(ks + 4 * AT_KP + 64); }
        else { const char* ks = kb + (size_t)s4 * kseg;
            a00 = *(const bf16x8*)(ks + k0o); a01 = *(const bf16x8*)(ks + k0o + 64); a10 = *(const bf16x8*)(ks + k1o); a11 = *(const bf16x8*)(ks + k1o + 64); }
        f32x4 c0 = (f32x4){0.f, 0.f, 0.f, 0.f}, c1 = (f32x4){0.f, 0.f, 0.f, 0.f};
        c0 = __builtin_amdgcn_mfma_f32_16x16x32_bf16(a00, q0, c0, 0, 0, 0);
        c0 = __builtin_amdgcn_mfma_f32_16x16x32_bf16(a01, q1, c0, 0, 0, 0);
        c1 = __builtin_amdgcn_mfma_f32_16x16x32_bf16(a10, q0, c1, 0, 0, 0);
        c1 = __builtin_amdgcn_mfma_f32_16x16x32_bf16(a11, q1, c1, 0, 0, 0);
        S[s4][0] = c0; S[s4][1] = c1;
        if (FROM_LDS) asm volatile("" ::: "memory");
    }
    if (!FROM_LDS) {
        asm volatile("" ::: "memory");
#pragma unroll
        for (int s4 = 2; s4 < 4; ++s4)
#pragma unroll
            for (int db = 0; db < 4; ++db) Vf[s4][db] = *(const bf16x8*)(vb + (size_t)s4 * vseg + (size_t)db * vrow16 + vo);
    }
    if (MASK) {
#pragma unroll
        for (int s4 = 0; s4 < 4; ++s4) { LAS const float* rr = rb + s4 * 31;
#pragma unroll
            for (int t = 0; t < 2; ++t)
#pragma unroll
                for (int e = 0; e < 4; ++e) { const int kc = band0 + 8 * g + 4 * t + e; const bool ok = (kc >= win0) && (kc < win0 + 16);
                    const int dc = min(max(kc - qc + 15, 0), 30);
                    S[s4][t][e] = ok ? S[s4][t][e] + rr[dc] : -INFINITY; } }
    }
    float mx = -INFINITY;
#pragma unroll
    for (int s4 = 0; s4 < 4; ++s4)
#pragma unroll
        for (int t = 0; t < 2; ++t)
#pragma unroll
            for (int e = 0; e < 4; ++e) mx = fmaxf(mx, S[s4][t][e]);
    mx = fmaxf(mx, __shfl_xor(mx, 16)); mx = fmaxf(mx, __shfl_xor(mx, 32));
    const float mnew = fmaxf(m_run, mx);
    const float scl = __builtin_amdgcn_exp2f((m_run - mnew) * 1.4426950408889634f);
    m_run = mnew;
    float ps = 0.f;
#pragma unroll
    for (int s4 = 0; s4 < 4; ++s4)
#pragma unroll
        for (int t = 0; t < 2; ++t)
#pragma unroll
            for (int e = 0; e < 4; ++e) { const float p = __builtin_amdgcn_exp2f((S[s4][t][e] - mnew) * 1.4426950408889634f); S[s4][t][e] = p; ps += p; }
    ps += __shfl_xor(ps, 16); ps += __shfl_xor(ps, 32);
    sum = sum * scl + ps;
#pragma unroll
    for (int db = 0; db < 4; ++db) O[db] = O[db] * scl;
#pragma unroll
    for (int s4 = 0; s4 < 4; ++s4) {
        u32x4 pw; pw.x = cvt_pk_bf16(S[s4][0][0], S[s4][0][1]); pw.y = cvt_pk_bf16(S[s4][0][2], S[s4][0][3]); pw.z = cvt_pk_bf16(S[s4][1][0], S[s4][1][1]); pw.w = cvt_pk_bf16(S[s4][1][2], S[s4][1][3]);
        const bf16x8 pf = __builtin_bit_cast(bf16x8, pw);
#pragma unroll
        for (int db = 0; db < 4; ++db) { if (FROM_LDS) Vf[s4][db] = *(LAS const bf16x8*)(lv + db * vrow16 + s4 * vseg);
            O[db] = __builtin_amdgcn_mfma_f32_16x16x32_bf16(Vf[s4][db], pf, O[db], 0, 0, 0); }
        if (FROM_LDS) asm volatile("" ::: "memory");
    }
    asm volatile("" ::: "memory");
}

__device__ __forceinline__ void attn_ctx_tile(const Args& a, LAS unsigned char* lds, int b, int h, int qt, int lane) {
    const char* BB = (const char*)(a.ws + WS_BIG);
    bf16_t* Y = (bf16_t*)(a.ws + WS_Y);
    const int ql = lane & 15, g = lane >> 4;
    const int qtok0 = b * LP + qt * 16;
    const char* qb = BB + (BQ_OFF + (size_t)qtok0 * D + h * HD) * 2;
    const int ci0 = 8 * (ql >> 2) + (ql & 3);
    const bf16x8 q0 = *(const bf16x8*)(qb + (unsigned)((ql * D + 8 * g) * 2)), q1 = *(const bf16x8*)(qb + (unsigned)((ql * D + 8 * g) * 2) + 64);
    LAS const unsigned char* lk = lds + AT_K_OFF + ci0 * AT_KP + 16 * g;
    LAS const unsigned char* lv = lds + AT_V_OFF + ql * AT_VP + 16 * g;
    float m_run = -INFINITY, sum = 0.f;
    f32x4 O[4];
#pragma unroll
    for (int db = 0; db < 4; ++db) O[db] = (f32x4){0.f, 0.f, 0.f, 0.f};
#pragma unroll 1
    for (int c = 0; c < 2; ++c)
        attn_chunk<true, false>(O, m_run, sum, q0, q1, nullptr, nullptr, 32 * AT_KP, 64, 16 * AT_VP, 0u, 0u, 0u, lk + c * 128 * AT_KP, lv + c * 256, (LAS const float*)lds, 0, g, 0, 0);
    const float inv = 1.0f / sum;
    bf16_t* op = Y + (size_t)(qtok0 + ql) * D + h * HD + 4 * g;
#pragma unroll
    for (int db = 0; db < 4; ++db) { u32x2 w; w.x = cvt_pk_bf16(O[db][0] * inv, O[db][1] * inv); w.y = cvt_pk_bf16(O[db][2] * inv, O[db][3] * inv); *(u32x2*)(op + db * 16) = w; }
}

__device__ __forceinline__ void attn_stage_local(const Args& a, LAS unsigned char* lds, int b, int h, int rowmin, int nrows, int cbase) {
    const int tid = opaque_tid();
    const char* BB = (const char*)(a.ws + WS_BIG);
    const char* ks = BB + (BK_OFF + (size_t)NPTOK * D + ((size_t)(b * NH + h) * LSQ + rowmin * 64 + cbase) * HD) * 2;
    const char* vs = BB + (BVS_OFF + ((size_t)(b * NH + h) * HD) * VPS + rowmin * 64 + cbase) * 2;
    const int total = nrows * 320, n5 = nrows * 5;
    { u32x4 kv[7];
#pragma unroll
      for (int k = 0; k < 7; ++k) { const int p = tid + NTHR * k;
          if (p < total) { const int kr = p / 320, rem = p - kr * 320; kv[k] = *(const u32x4*)(ks + (size_t)kr * (64 * 128) + rem * 16); } }
#pragma unroll
      for (int k = 0; k < 7; ++k) { const int p = tid + NTHR * k;
          if (p < total) { const int kr = p / 320, rem = p - kr * 320, key = rem >> 3, c16 = rem & 7; *(LAS u32x4*)(lds + AT_LK_OFF + (kr * 40 + key) * AT_KP + c16 * 16) = kv[k]; } } }
    asm volatile("" ::: "memory");
    { u32x4 vv[7];
#pragma unroll
      for (int k = 0; k < 7; ++k) { const int p = tid + NTHR * k;
          if (p < total) { const int d = p / n5, rm = p - d * n5, kr2 = rm / 5, c16 = rm - kr2 * 5; vv[k] = *(const u32x4*)(vs + (size_t)d * (VPS * 2) + kr2 * 128 + c16 * 16); } }
#pragma unroll
      for (int k = 0; k < 7; ++k) { const int p = tid + NTHR * k;
          if (p < total) { const int d = p / n5, rm = p - d * n5, kr2 = rm / 5, c16v = rm - kr2 * 5; *(LAS u32x4*)(lds + AT_LV_OFF + d * AT_LVP + kr2 * 80 + c16v * 16) = vv[k]; } } }
}

__device__ __forceinline__ void attn_latent_unit(const Args& a, LAS unsigned char* lds, int b, int h, int i4, int lane, int wave) {
    const char* BB = (const char*)(a.ws + WS_BIG);
    bf16_t* Y = (bf16_t*)(a.ws + WS_Y);
    LAS float* rpbh = (LAS float*)lds;
    const int tid = opaque_tid();
    const int rowmin = min(max(4 * i4 - 4, 0), 8), rowmax = min(max(4 * i4 - 1, 0), 8) + 7, nrows = rowmax - rowmin + 1;
    const int r = 4 * i4 + (wave >> 1), row0 = min(max(r - 4, 0), 8);
    const int ql = lane & 15, g = lane >> 4, ci0 = 8 * (ql >> 2) + (ql & 3);
    f32x4 O[2][4]; float m_run[2], sum[2];
#pragma unroll
    for (int pr = 0; pr < 2; ++pr) {
        const int j = 2 * pr + (wave & 1), cbase = 24 * pr, band0 = min(max(16 * j - 8, 0), 32), off = band0 - cbase;
        __syncthreads();
        if (pr == 0) { for (int i = tid; i < 465; i += NTHR) rpbh[i] = a.in[27][h * 465 + i]; }
        attn_stage_local(a, lds, b, h, rowmin, nrows, cbase);
        __syncthreads();
        const int qtok0 = NPTOK + b * LSQ + r * 64 + j * 16;
        const char* qb = BB + (BQ_OFF + (size_t)qtok0 * D + h * HD) * 2;
        const bf16x8 q0 = *(const bf16x8*)(qb + (unsigned)((ql * D + 8 * g) * 2)), q1 = *(const bf16x8*)(qb + (unsigned)((ql * D + 8 * g) * 2) + 64);
        m_run[pr] = -INFINITY; sum[pr] = 0.f;
#pragma unroll
        for (int db = 0; db < 4; ++db) O[pr][db] = (f32x4){0.f, 0.f, 0.f, 0.f};
        const int kl0 = (row0 - rowmin) * 40 + off;
        LAS const unsigned char* lk = lds + AT_LK_OFF + (kl0 + ci0) * AT_KP + 16 * g;
        LAS const unsigned char* lv = lds + AT_LV_OFF + ql * AT_LVP + (kl0 + 8 * g) * 2;
        const int qc = 16 * j + ql, win0 = min(max(qc - 8, 0), 48);
        LAS const float* rb = rpbh + (row0 - r + 7) * 31;
#pragma unroll 1
        for (int c = 0; c < 2; ++c)
            attn_chunk<true, true>(O[pr], m_run[pr], sum[pr], q0, q1, nullptr, nullptr, 40 * AT_KP, 80, 16 * AT_LVP, 0u, 0u, 0u,
                                   lk + c * 4 * 40 * AT_KP, lv + c * 4 * 80, rb + c * 4 * 31, band0, g, qc, win0);
    }
    __syncthreads();
    attn_stage_kv(lds, (const char*)(a.ws + WS_CK) + (size_t)(b * NH + h) * 256 * HD * 2, (const char*)(a.ws + WS_CVT) + (size_t)(b * NH + h) * HD * CVP * 2, CVP * 2);
    __syncthreads();
    {
        LAS const unsigned char* lk = lds + AT_K_OFF + ci0 * AT_KP + 16 * g;
        LAS const unsigned char* lv = lds + AT_V_OFF + ql * AT_VP + 16 * g;
#pragma unroll
        for (int pr = 0; pr < 2; ++pr) {
            const int j = 2 * pr + (wave & 1);
            const int qtok0 = NPTOK + b * LSQ + r * 64 + j * 16;
            const char* qb = BB + (BQ_OFF + (size_t)qtok0 * D + h * HD) * 2;
            const bf16x8 q0 = *(const bf16x8*)(qb + (unsigned)((ql * D + 8 * g) * 2)), q1 = *(const bf16x8*)(qb + (unsigned)((ql * D + 8 * g) * 2) + 64);
#pragma unroll 1
            for (int c = 0; c < 2; ++c)
                attn_chunk<true, false>(O[pr], m_run[pr], sum[pr], q0, q1, nullptr, nullptr, 32 * AT_KP, 64, 16 * AT_VP, 0u, 0u, 0u, lk + c * 128 * AT_KP, lv + c * 256, rpbh, 0, g, 0, 0);
            const float inv = 1.0f / sum[pr];
            bf16_t* op = Y + (size_t)(qtok0 + ql) * D + h * HD + 4 * g;
#pragma unroll
            for (int db = 0; db < 4; ++db) { u32x2 w; w.x = cvt_pk_bf16(O[pr][db][0] * inv, O[pr][db][1] * inv); w.y = cvt_pk_bf16(O[pr][db][2] * inv, O[pr][db][3] * inv); *(u32x2*)(op + db * 16) = w; }
        }
    }
}

__device__ __forceinline__ void attn_phase(const Args& a, LAS unsigned char* lds) {
    const int tid = opaque_tid(), lane = tid & 63, wave = __builtin_amdgcn_readfirstlane(tid >> 6), bx = blockIdx.x, G = gridDim.x;
    const int vcu = (G % 8 == 0) ? (bx % 8) * (G / 8) + bx / 8 : bx;
    const char* BB = (const char*)(a.ws + WS_BIG);
    for (int u = vcu; u < 256; u += G) { const int bh = u >> 2; attn_latent_unit(a, lds, bh >> 4, bh & 15, u & 3, lane, wave); }
    for (int u = vcu; u < 256; u += G) {
        const int b = u >> 4, h = u & 15;
        __syncthreads();
        attn_stage_kv(lds, BB + (BK_OFF + (size_t)u * LP * HD) * 2, BB + (BV_OFF + (size_t)u * HD * VPP) * 2, VPP * 2);
        __syncthreads();
#pragma unroll 1
        for (int tt = 0; tt < 2; ++tt) attn_ctx_tile(a, lds, b, h, 2 * wave + tt, lane);
    }
    __syncthreads();
}

__device__ __forceinline__ void cache_convert(const Args& a, int slot, int nslots) {
    const int tid = opaque_tid();
    const int gt = slot * NTHR + tid, NGT = nslots * NTHR;
    for (int i = gt; i < 131072; i += NGT) {
        const f32x4 x0 = *(const f32x4*)(a.in[2] + (size_t)i * 8), x1 = *(const f32x4*)(a.in[2] + (size_t)i * 8 + 4);
        u32x4 o; o.x = cvt_pk_bf16(x0[0], x0[1]); o.y = cvt_pk_bf16(x0[2], x0[3]); o.z = cvt_pk_bf16(x1[0], x1[1]); o.w = cvt_pk_bf16(x1[2], x1[3]);
        *(u32x4*)((bf16_t*)(a.ws + WS_CK) + (size_t)i * 8) = o;
        const int d = i & 63, sg = (i >> 6) & 31, bh = i >> 11;
        const float* src = a.in[3] + ((size_t)bh * 256 + 8 * sg) * 64 + d;
        u32x4 p; p.x = cvt_pk_bf16(src[0], src[64]); p.y = cvt_pk_bf16(src[128], src[192]); p.z = cvt_pk_bf16(src[256], src[320]); p.w = cvt_pk_bf16(src[384], src[448]);
        *(u32x4*)((bf16_t*)(a.ws + WS_CVT) + ((size_t)bh * 64 + d) * CVP + 8 * sg) = p;
    }
}

#ifndef PHASES
#define PHASES 0xFFFFFFFFu
#endif
#define PH(k) ((PHASES >> (k)) & 1u)
#ifndef REP
#define REP 0x0u
#endif
#ifndef HYREP
#define HYREP 0x0u
#endif
#ifndef XSYNC
#define XSYNC 0
#endif
#define RP(k) for (int rep_ = 0; rep_ <= (int)((REP >> (k)) & 1u); ++rep_)
__global__ void __launch_bounds__(NTHR, 2) fwd_megakernel(Args a) {
    extern __shared__ __attribute__((aligned(16))) unsigned char lds_raw[];
    LAS unsigned char* lds = (LAS unsigned char*)lds_raw;
    cg::grid_group grid = cg::this_grid();
    if (a.ws == nullptr) grid.sync();
    if (opaque_tid() < 64) ((volatile LAS unsigned*)(lds + LDS_CTL))[opaque_tid()] = 0u;
    __syncthreads();
    const XcdBarrier xbar = xcd_barrier_post((unsigned*)(a.ws + WS_BAR), (volatile LAS unsigned*)(lds + LDS_CTL));
#define GSYNC() xcd_barrier(xbar)
#define LSYNC() do { if (xl_ok) xcd_local_barrier(xbar); else xcd_barrier(xbar); } while (0)
#define IDLE_DEFER(ntot, r0, r1, cid) do { const int rounds_ = ((ntot) + G - 1) / G, nidle_ = rounds_ * G - (ntot); \
    if (nidle_ > 0) { if (cid >= G - nidle_) deferred_transposes(a, lds, r0, r1, cid - (G - nidle_), nidle_); } else deferred_transposes(a, lds, r0, r1, cid, G); } while (0)
    const int G = gridDim.x, bx = blockIdx.x;
    unsigned char* ws = a.ws;
    const float* ada = (const float*)(ws + WS_ADA);
    bf16_t* H = (bf16_t*)(ws + WS_H); bf16_t* Yb = (bf16_t*)(ws + WS_Y);
    bf16_t* X = (bf16_t*)(ws + WS_X); bf16_t* P0 = (bf16_t*)(ws + WS_P0); bf16_t* P1 = (bf16_t*)(ws + WS_P1);
    bf16_t* BIG = (bf16_t*)(ws + WS_BIG);

    RP(0) { if (PH(0)) { p0_prep(a, lds); }
      GSYNC(); }
    const unsigned xl_ok = (unsigned)__builtin_amdgcn_readfirstlane((int)xbar.st[2]);
    const int vb = xl_ok ? __builtin_amdgcn_readfirstlane((int)(xbar.st[3] * 8u + xbar.x)) : bx;
    const int vbln = xl_ok ? vb : -1;

    RP(2) { if (PH(2)) { { pg8::Gemm g{(const bf16_t*)(ws + WS_WHYIN), H, 1024, 1024}; pg8::Order S; S.init(3072, NTOK, 1, G, bx);
      pg8::EpiBf16T E{BIG, NTOK}; pg8::gemm_phase(lds, g, S, E); }
      { const int nidle_c = 2 * G - 384; if (nidle_c > 0 && nidle_c <= G) { if (bx >= G - nidle_c) cache_convert(a, bx - (G - nidle_c), nidle_c); } else cache_convert(a, bx, G); }
      IDLE_DEFER(384, TR_S1_BEG, TR_S1_END, bx); }
      GSYNC(); }
    RP(3) { if (PH(3)) { { for (int it = bx; it < 256; it += G) { hyena_item<1024, 2>(a, lds, 8 * (it >> 1), NPTOK + 2048 * (it & 1)); hyena_item<256, 8>(a, lds, 8 * (it >> 1), 2048 * (it & 1)); } } }
      GSYNC(); }
    RP(4) { if (PH(4)) { { pg8::Gemm g{Yb, (const bf16_t*)(ws + WS_WHYOUT), 512, 1024}; pg8::Order S; S.init(NTOK, 1024, 2, G, vb);
      pg8::EpiRes<true> E{a.in[0], a.in[1], ada + 2048, P0, P1}; pg8::gemm_phase(lds, g, S, E); } }
      LSYNC(); }
    RP(5) { if (PH(5)) { ln_phase<false>(a, a.in[8], a.in[9], nullptr, ada + 3072, vbln, a.in[0], a.in[1]); }
      LSYNC(); }
    RP(6) { if (PH(6)) { { pg8::Gemm g{H, (const bf16_t*)(ws + WS_WFFIN), 1024, 1024}; pg8::Order S; S.init(NTOK, 5632, 1, G, vb);
      pg8::EpiSwiglu E{BIG}; pg8::gemm_phase(lds, g, S, E); }
      IDLE_DEFER(704, TR_S2_BEG, TR_S2_END, vb); }
      LSYNC(); }
    RP(7) { if (PH(7)) { { pg8::Gemm g{BIG, (const bf16_t*)(ws + WS_WFFOUT), 1408, DFF}; pg8::Order S; S.init(NTOK, 1024, 2, G, vb);
      pg8::EpiRes<false> E{X, X + (size_t)NPTOK * D, ada + 5120, P0, P1}; pg8::gemm_phase(lds, g, S, E); } }
      LSYNC(); }
    RP(8) { if (PH(8)) { ln_phase<false>(a, a.in[10], a.in[11], nullptr, ada + 5 * 6144, vbln);   }
      GSYNC(); }

    for (int xs_ = 0; xs_ < XSYNC; ++xs_) GSYNC();
    RP(9) { if (PH(9)) { { pg8::Gemm g{H, (const bf16_t*)(ws + WS_WQKV), 1024, 1024}; pg8::Order S; S.init(NTOK, 3072, 1, G, bx);
      pg8::EpiQKV E{BIG, a.out + (size_t)NTOK * D, a.out + (size_t)NTOK * D + (size_t)NPTOK * D}; pg8::gemm_phase(lds, g, S, E); }
      IDLE_DEFER(384, TR_S3_BEG, TR_S3_END, bx); }
      GSYNC(); }
    RP(10) { if (PH(10)) { attn_phase(a, lds); }
      GSYNC(); }
    RP(11) { if (PH(11)) { { pg8::Gemm g{Yb, (const bf16_t*)(ws + WS_WNAOUT), 512, 1024}; pg8::Order S; S.init(NTOK, 1024, 2, G, vb);
      pg8::EpiRes<false> E{X, X + (size_t)NPTOK * D, ada + 5 * 6144 + 2048, P0, P1}; pg8::gemm_phase(lds, g, S, E); } }
      LSYNC(); }
    RP(12) { if (PH(12)) { ln_phase<false>(a, a.in[8] + D, a.in[9] + D, nullptr, ada + 5 * 6144 + 3072, vbln); }
      LSYNC(); }
    RP(13) { if (PH(13)) { { pg8::Gemm g{H, (const bf16_t*)(ws + WS_WFFIN) + (size_t)5632 * 1024, 1024, 1024}; pg8::Order S; S.init(NTOK, 5632, 1, G, vb);
      pg8::EpiSwiglu E{BIG}; pg8::gemm_phase(lds, g, S, E); } }
      LSYNC(); }
    RP(14) { if (PH(14)) { { pg8::Gemm g{BIG, (const bf16_t*)(ws + WS_WFFOUT) + (size_t)1024 * DFF, 1408, DFF}; pg8::Order S; S.init(NTOK, 1024, 2, G, vb);
      pg8::EpiRes<false> E{X, X + (size_t)NPTOK * D, ada + 5 * 6144 + 5120, P0, P1}; pg8::gemm_phase(lds, g, S, E); } }
      LSYNC(); }
    RP(15) { if (PH(15)) { ln_phase<true>(a, a.in[10] + D, a.in[11] + D, a.out, ada, vbln); } }
}

extern "C" void kernel_launch(void* const* d_in, const int* in_sizes, int n_in, void* d_out, int out_size, void* d_ws, size_t ws_size, hipStream_t stream) {
    static int grid = 0;
    if (grid == 0) {
        if (n_in != 29 || ws_size < WS_END) { fprintf(stderr, "kernel_launch: unexpected n_in %d or ws_size %zu (need %zu)\n", n_in, ws_size, (size_t)WS_END); grid = -1; return; }
        int dev = 0, cus = 0, per_cu = 0;
        hipGetDevice(&dev);
        hipDeviceGetAttribute(&cus, hipDeviceAttributeMultiprocessorCount, dev);
        if (hipFuncSetAttribute((const void*)fwd_megakernel, hipFuncAttributeMaxDynamicSharedMemorySize, LDS_BYTES) != hipSuccess) { fprintf(stderr, "kernel_launch: hipFuncSetAttribute failed\n"); grid = -1; return; }
        if (hipOccupancyMaxActiveBlocksPerMultiprocessor(&per_cu, (const void*)fwd_megakernel, NTHR, LDS_BYTES) != hipSuccess || per_cu < 1) { fprintf(stderr, "kernel_launch: occupancy query says %d\n", per_cu); per_cu = 1; }
        (void)hipGetLastError();
        grid = cus;
        if (grid > 256) grid = 256;
    }
    if (grid < 0) return;
    if (hipMemsetAsync((char*)d_ws + WS_BAR, 0, XB_ALL_WORDS * 4, stream) != hipSuccess) { fprintf(stderr, "kernel_launch: memset failed\n"); return; }
    Args a{};
    for (int i = 0; i < 29; ++i) a.in[i] = (const float*)d_in[i];
    a.out = (float*)d_out; a.ws = (unsigned char*)d_ws;
    void* args[] = {&a};
    hipError_t e = hipLaunchCooperativeKernel((const void*)fwd_megakernel, dim3(grid), dim3(NTHR), args, LDS_BYTES, stream);
    if (e != hipSuccess) fprintf(stderr, "cooperative launch failed: %s (grid %d)\n", hipGetErrorString(e), grid);
}
```

```cpp
#include <hip/hip_runtime.h>
#include <hip/hip_cooperative_groups.h>
#include <cstdio>
#include <cstdint>
namespace cg = cooperative_groups;

#define LAS __attribute__((address_space(3)))
typedef unsigned short bf16_t;
typedef short bf16x8 __attribute__((ext_vector_type(8)));
typedef float f32x4 __attribute__((ext_vector_type(4)));
typedef float f32x16 __attribute__((ext_vector_type(16)));
typedef unsigned u32x4 __attribute__((ext_vector_type(4)));
typedef unsigned u32x2 __attribute__((ext_vector_type(2)));

#ifndef HYREP
#define HYREP 0x0u
#endif
#ifndef P0REP
#define P0REP 0x0u
#endif
constexpr int D = 1024, NTOK = 8192, NPTOK = 4096, LP = 256, LSQ = 1024, DFF = 2816, NH = 16, HD = 64;
constexpr float ALPHA_C = 1.4142135623730951f;
constexpr float LN_EPS_C = 1e-5f;
constexpr int NWAVES = 8, NTHR = 512;
constexpr int LDS_BYTES = 147456;
constexpr int HY_WSTR = 17408;
constexpr int LDS_CTL = 8 * HY_WSTR;
constexpr int HY_ZERO = LDS_CTL + 64;

constexpr size_t MB = 1024 * 1024;
constexpr size_t WS_ADA    = 0;
constexpr size_t WS_BAR    = 245760;
constexpr size_t WS_WHYIN  = 256 * 1024;
constexpr size_t WS_WHYOUT = WS_WHYIN + 6 * MB;
constexpr size_t WS_WQKV   = WS_WHYOUT + 2 * MB;
constexpr size_t WS_WNAOUT = WS_WQKV + 6 * MB;
constexpr size_t WS_WFFIN  = WS_WNAOUT + 2 * MB;
constexpr size_t WS_WFFOUT = WS_WFFIN + 22 * MB;
constexpr size_t WS_RF256  = WS_WFFOUT + 11 * MB;
constexpr size_t WS_RF1024 = WS_RF256 + 1 * MB;
constexpr size_t WS_CK     = WS_RF1024 + 4 * MB;
constexpr size_t WS_CVT    = WS_CK + 2 * MB;
constexpr size_t WS_H      = WS_CVT + 4 * MB;
constexpr size_t WS_Y      = WS_H + 16 * MB;
constexpr size_t WS_X      = WS_Y + 16 * MB;
constexpr size_t WS_P0     = WS_X + 32 * MB;
constexpr size_t WS_P1     = WS_P0 + 32 * MB;
constexpr size_t WS_BIG    = WS_P1 + 32 * MB;
constexpr size_t WS_END    = WS_BIG + 64 * MB;
constexpr int VPP = 384, VPS = 1152, CVP = 384;
constexpr size_t BQ_OFF = 0, BK_OFF = (size_t)NTOK * D, BV_OFF = 2 * (size_t)NTOK * D, BVS_OFF = BV_OFF + (size_t)16 * NH * HD * VPP;

__device__ __forceinline__ int opaque_tid() { int t = threadIdx.x; asm volatile("" : "+v"(t)); return t; }
typedef float f32x2 __attribute__((ext_vector_type(2)));
typedef __bf16 bf16x2v __attribute__((ext_vector_type(2)));
__device__ __forceinline__ unsigned cvt_pk_bf16(float lo, float hi) { const f32x2 v = {lo, hi}; const bf16x2v b = __builtin_convertvector(v, bf16x2v); return __builtin_bit_cast(unsigned, b); }
__device__ __forceinline__ bf16_t f2bf(float x) { return (bf16_t)(cvt_pk_bf16(x, 0.f) & 0xffffu); }
__device__ __forceinline__ float bf2f(bf16_t b) { return __uint_as_float(((unsigned)b) << 16); }
__device__ __forceinline__ float bflo(unsigned w) { return __uint_as_float(w << 16); }
__device__ __forceinline__ float bfhi(unsigned w) { return __uint_as_float(w & 0xffff0000u); }
__device__ __forceinline__ float silu_f(float x) { return x * __builtin_amdgcn_rcpf(1.0f + __builtin_amdgcn_exp2f(-1.4426950408889634f * x)); }
__device__ __forceinline__ float wave_sum(float v) {
#pragma unroll
    for (int o = 1; o < 64; o <<= 1) v += __shfl_xor(v, o);
    return v;
}

namespace pg8 {
constexpr int BM = 256, BK = 64, HALF = 128, HTB = HALF * BK * 2, STAGE_BYTES = 8 * HTB, NXCD = 8, WGM = 4;
__device__ __forceinline__ int lds_byte(int r, int c) { const int st = (r >> 4) * 2 + (c >> 5), rr = r & 15, cc = c & 31, ob = rr * 64 + cc * 2; return st * 1024 + (ob ^ (((ob >> 9) & 1) << 5)); }
__device__ __forceinline__ void stage_rc(int b, int& R, int& C) { const int st = b / 1024, sb = b % 1024, swz = sb ^ (((sb >> 9) & 1) << 5); R = (st >> 1) * 16 + swz / 64; C = (st & 1) * 32 + (swz % 64) / 2; }
__device__ __forceinline__ int perm32(int rho) { const int n = rho >> 4, i = rho & 15; return 8 * (i >> 2) + 4 * n + (i & 3); }

struct Unit { int pm, pn, kh; };
struct Gemm { const bf16_t* A; const bf16_t* Bt; int K; int ld; };

struct Order {
    int nM, nN, nmn, ntot, G, c;
    __device__ void init(int M, int N, int ks, int G_, int c_) { nM = M / BM; nN = N / BM; nmn = nM * nN; ntot = nmn * ks; G = G_; c = c_; }
    __device__ bool next(int i, Unit& u) const {
        const int L = i * G + c; if (L >= ntot) return false;
        u.kh = L / nmn; int wgid = L - u.kh * nmn;
        { const int q = nmn / NXCD, r = nmn % NXCD, xcd = wgid % NXCD, off = wgid / NXCD; wgid = (xcd < r ? xcd * (q + 1) : r * (q + 1) + (xcd - r) * q) + off; }
        const int nig = WGM * nN, gid = wgid / nig, fm = gid * WGM, gsz = (nM - fm) < WGM ? (nM - fm) : WGM;
        u.pm = fm + ((wgid % nig) % gsz); u.pn = (wgid % nig) / gsz; return true;
    }
};

template <class Epi>
__device__ __forceinline__ void gemm_phase(LAS unsigned char* lds, const Gemm g, const Order& S, const Epi& E) {
    const int tid = opaque_tid(), wid = __builtin_amdgcn_readfirstlane(tid >> 6), lane = tid & 63, wr = wid >> 2, wc = wid & 3, fr = lane & 15, fq = lane >> 4;
    const int K = g.ld, nt = g.K / BK;
    unsigned voffA[2], voffB[2];
#pragma unroll
    for (int i = 0; i < 2; ++i) { int R, C; stage_rc(tid * 16 + i * 8192, R, C); const int Rb = Epi::PERM ? ((R & ~31) + perm32(R & 31)) : R;
        voffA[i] = (unsigned)(R * K + C) * 2u; voffB[i] = (unsigned)(Rb * K + C) * 2u; }
    const size_t kstep = (size_t)(BK * 2);
    const size_t hstep = (size_t)HALF * K * 2;
    const size_t tstep = 2 * hstep;
    const size_t khstep = (size_t)g.K * 2;
    const unsigned ldsw = (unsigned)wid * 1024u;
    const int aoff = lds_byte(wr * 64 + fr, fq * 8), boff = lds_byte(wc * 32 + fr, fq * 8);
#define PG8_SA(b, h) (((b) * 2 + (h)) * HTB)
#define PG8_SB(b, h) ((4 + (b) * 2 + (h)) * HTB)
#define PG8_STAGE(bufoff, gbase, voff) do { _Pragma("unroll") for (int _i = 0; _i < 2; ++_i) \
        __builtin_amdgcn_global_load_lds((const unsigned*)((const char*)(gbase) + (voff)[_i]), (LAS unsigned*)(lds + (bufoff) + ldsw + _i * 8192), 16, 0, 0); } while (0)
#define PG8_LDA(dst, b, h) do { _Pragma("unroll") for (int m = 0; m < 4; ++m) _Pragma("unroll") for (int k = 0; k < 2; ++k) dst[m][k] = *(const LAS bf16x8*)(lds + PG8_SA(b, h) + aoff + m * 2048 + k * 1024); } while (0)
#define PG8_LDB(dst, b, h) do { _Pragma("unroll") for (int n = 0; n < 2; ++n) _Pragma("unroll") for (int k = 0; k < 2; ++k) dst[n][k] = *(const LAS bf16x8*)(lds + PG8_SB(b, h) + boff + n * 2048 + k * 1024); } while (0)
#define PG8_MMA(ai, bj, At, Bt) do { __builtin_amdgcn_s_setprio(1); _Pragma("unroll") for (int m = 0; m < 4; ++m) _Pragma("unroll") for (int n = 0; n < 2; ++n) _Pragma("unroll") for (int k = 0; k < 2; ++k) \
        acc[ai][bj][m][n] = __builtin_amdgcn_mfma_f32_16x16x32_bf16(Bt[n][k], At[m][k], acc[ai][bj][m][n], 0, 0, 0); __builtin_amdgcn_s_setprio(0); } while (0)
#define PG8_WAIT_V(n) asm volatile("s_waitcnt vmcnt(" #n ")" ::: "memory")
#define PG8_WAIT_L(n) asm volatile("s_waitcnt lgkmcnt(" #n ")" ::: "memory")
#define PG8_BAR __builtin_amdgcn_s_barrier()
#define PG8_SCHED __builtin_amdgcn_sched_barrier(0)
    Unit cur, nxt; int ui = 0;
    if (!S.next(0, cur)) return;
    f32x4 acc[2][2][4][2];
#pragma unroll
    for (int a = 0; a < 2; ++a)
#pragma unroll
        for (int b = 0; b < 2; ++b)
#pragma unroll
            for (int m = 0; m < 4; ++m)
#pragma unroll
                for (int n = 0; n < 2; ++n) acc[a][b][m][n] = (f32x4){0.f, 0.f, 0.f, 0.f};
    bf16x8 At[4][2], B0[2][2], B1[2][2];
    const char* cA = (const char*)g.A + (size_t)cur.pm * tstep + (size_t)cur.kh * khstep; const char* cB = (const char*)g.Bt + (size_t)cur.pn * tstep + (size_t)cur.kh * khstep;
    PG8_STAGE(PG8_SB(0, 0), cB, voffB); PG8_STAGE(PG8_SB(0, 1), cB + hstep, voffB); PG8_STAGE(PG8_SA(0, 0), cA, voffA); PG8_STAGE(PG8_SA(0, 1), cA + hstep, voffA);
    if (wr == 1) PG8_BAR;
    PG8_WAIT_V(2); PG8_BAR;
    PG8_STAGE(PG8_SB(1, 0), cB + kstep, voffB); PG8_STAGE(PG8_SA(1, 0), cA + kstep, voffA); PG8_STAGE(PG8_SB(1, 1), cB + hstep + kstep, voffB);
    PG8_WAIT_V(6); PG8_BAR;
    for (;;) {
        const bool has_next = S.next(ui + 1, nxt);
        const char* nA = has_next ? (const char*)g.A + (size_t)nxt.pm * tstep + (size_t)nxt.kh * khstep : cA; const char* nB = has_next ? (const char*)g.Bt + (size_t)nxt.pn * tstep + (size_t)nxt.kh * khstep : cB;
        for (int t = 0; t < nt; t += 2) {
            const bool last = (t == nt - 2);
            const char* a1 = cA + (size_t)(t + 1) * kstep;
            const char* a2 = last ? nA : cA + (size_t)(t + 2) * kstep; const char* b2 = last ? nB : cB + (size_t)(t + 2) * kstep;
            const char* a3 = a2 + kstep; const char* b3 = b2 + kstep;
            PG8_LDB(B0, 0, 0); PG8_LDB(B1, 0, 1); PG8_SCHED; PG8_LDA(At, 0, 0); PG8_STAGE(PG8_SA(1, 1), a1 + hstep, voffA);
            PG8_WAIT_V(8); PG8_WAIT_L(0); PG8_BAR; PG8_MMA(0, 0, At, B0); PG8_MMA(0, 1, At, B1); PG8_BAR; PG8_SCHED;
            PG8_LDA(At, 0, 1); PG8_STAGE(PG8_SB(0, 0), b2, voffB); PG8_STAGE(PG8_SB(0, 1), b2 + hstep, voffB); PG8_STAGE(PG8_SA(0, 0), a2, voffA);
            PG8_WAIT_V(8); PG8_WAIT_L(0); PG8_BAR; PG8_MMA(1, 0, At, B0); PG8_MMA(1, 1, At, B1); PG8_BAR; PG8_SCHED;
            PG8_LDB(B0, 1, 0); PG8_LDB(B1, 1, 1); PG8_SCHED; PG8_LDA(At, 1, 0); PG8_STAGE(PG8_SA(0, 1), a2 + hstep, voffA);
            PG8_WAIT_V(8); PG8_WAIT_L(0); PG8_BAR; PG8_MMA(0, 0, At, B0); PG8_MMA(0, 1, At, B1); PG8_BAR; PG8_SCHED;
            PG8_LDA(At, 1, 1); PG8_STAGE(PG8_SB(1, 0), b3, voffB); PG8_STAGE(PG8_SB(1, 1), b3 + hstep, voffB); PG8_STAGE(PG8_SA(1, 0), a3, voffA);
            PG8_WAIT_V(8); PG8_WAIT_L(0); PG8_BAR; PG8_MMA(1, 0, At, B0); PG8_MMA(1, 1, At, B1); PG8_BAR; PG8_SCHED;
        }
        if (wr == 0) PG8_BAR;
        E(acc, cur, wr, wc, fr, fq);
        if (!has_next) break;
#pragma unroll
        for (int a = 0; a < 2; ++a)
#pragma unroll
            for (int b = 0; b < 2; ++b)
#pragma unroll
                for (int m = 0; m < 4; ++m)
#pragma unroll
                    for (int n = 0; n < 2; ++n) acc[a][b][m][n] = (f32x4){0.f, 0.f, 0.f, 0.f};
        cur = nxt; cA = nA; cB = nB; ++ui;
        if (wr == 1) PG8_BAR;
    }
    PG8_WAIT_V(0);
    PG8_BAR;
#undef PG8_SA
#undef PG8_SB
#undef PG8_STAGE
#undef PG8_LDA
#undef PG8_LDB
#undef PG8_MMA
#undef PG8_WAIT_V
#undef PG8_WAIT_L
#undef PG8_BAR
#undef PG8_SCHED
}

struct EpiBf16T {
    static constexpr bool PERM = true;
    bf16_t* O; int ldc;
    __device__ __forceinline__ void operator()(const f32x4 (&acc)[2][2][4][2], const Unit& u, int wr, int wc, int fr, int fq) const {
        const int row0 = u.pm * BM + wr * 64 + fr, col0 = u.pn * BM + wc * 32 + 8 * fq;
#pragma unroll
        for (int ai = 0; ai < 2; ++ai)
#pragma unroll
            for (int m = 0; m < 4; ++m) { bf16_t* rowp = O + (size_t)(row0 + ai * HALF + m * 16) * ldc + col0;
#pragma unroll
                for (int bj = 0; bj < 2; ++bj) { const f32x4 v0 = acc[ai][bj][m][0], v1 = acc[ai][bj][m][1];
                    u32x4 w; w.x = cvt_pk_bf16(v0[0], v0[1]); w.y = cvt_pk_bf16(v0[2], v0[3]); w.z = cvt_pk_bf16(v1[0], v1[1]); w.w = cvt_pk_bf16(v1[2], v1[3]);
                    *(u32x4*)(rowp + bj * HALF) = w; } }
    }
};
template <bool BASE_F32>
struct EpiRes {
    static constexpr bool PERM = true;
    const void* bp; const void* bs;
    const float* gate;
    bf16_t* P0; bf16_t* P1;
    __device__ __forceinline__ void operator()(const f32x4 (&acc)[2][2][4][2], const Unit& u, int wr, int wc, int fr, int fq) const {
        const int row0 = u.pm * BM + wr * 64 + fr, col0 = u.pn * BM + wc * 32 + 8 * fq;
        const int v = (u.pm < 16) ? 0 : 1 + ((u.pm - 16) >> 2);
        f32x4 gv[2][2];
#pragma unroll
        for (int bj = 0; bj < 2; ++bj)
#pragma unroll
            for (int n = 0; n < 2; ++n) gv[bj][n] = *(const f32x4*)(gate + v * 6144 + col0 + bj * HALF + 4 * n);
        bf16_t* P = u.kh ? P1 : P0;
#pragma unroll
        for (int ai = 0; ai < 2; ++ai)
#pragma unroll
            for (int m = 0; m < 4; ++m) { bf16_t* rowp = P + (size_t)(row0 + ai * HALF + m * 16) * D + col0;
#pragma unroll
                for (int bj = 0; bj < 2; ++bj) { const f32x4 y0 = gv[bj][0] * acc[ai][bj][m][0], y1 = gv[bj][1] * acc[ai][bj][m][1];
                    u32x4 w; w.x = cvt_pk_bf16(y0[0], y0[1]); w.y = cvt_pk_bf16(y0[2], y0[3]); w.z = cvt_pk_bf16(y1[0], y1[1]); w.w = cvt_pk_bf16(y1[2], y1[3]);
                    *(u32x4*)(rowp + bj * HALF) = w; } }
    }
};
struct EpiSwiglu {
    static constexpr bool PERM = true;
    bf16_t* O;
    __device__ __forceinline__ void operator()(const f32x4 (&acc)[2][2][4][2], const Unit& u, int wr, int wc, int fr, int fq) const {
        const int row0 = u.pm * BM + wr * 64 + fr;
#pragma unroll
        for (int ai = 0; ai < 2; ++ai)
#pragma unroll
            for (int m = 0; m < 4; ++m) { bf16_t* rowp = O + (size_t)(row0 + ai * HALF + m * 16) * DFF + u.pn * 128 + wc * 32 + 8 * fq;
                const f32x4 a0 = acc[ai][0][m][0], a1 = acc[ai][0][m][1], b0 = acc[ai][1][m][0], b1 = acc[ai][1][m][1];
                u32x4 w; w.x = cvt_pk_bf16(silu_f(a0[0]) * b0[0], silu_f(a0[1]) * b0[1]); w.y = cvt_pk_bf16(silu_f(a0[2]) * b0[2], silu_f(a0[3]) * b0[3]);
                w.z = cvt_pk_bf16(silu_f(a1[0]) * b1[0], silu_f(a1[1]) * b1[1]); w.w = cvt_pk_bf16(silu_f(a1[2]) * b1[2], silu_f(a1[3]) * b1[3]);
                *(u32x4*)rowp = w; }
    }
};
struct EpiQKV {
    static constexpr bool PERM = true;
    bf16_t* B; float* newk; float* newv;
    __device__ __forceinline__ void operator()(const f32x4 (&acc)[2][2][4][2], const Unit& u, int wr, int wc, int fr, int fq) const {
        const int row0 = u.pm * BM + wr * 64 + fr, col0 = u.pn * BM + wc * 32 + 8 * fq;
        const bool prompt = u.pm < 16;
        if (u.pn < 4) {
#pragma unroll
            for (int ai = 0; ai < 2; ++ai)
#pragma unroll
                for (int m = 0; m < 4; ++m) { const int row = row0 + ai * HALF + m * 16; bf16_t* rowp = B + BQ_OFF + (size_t)row * D + col0;
#pragma unroll
                    for (int bj = 0; bj < 2; ++bj) { const f32x4 x0 = acc[ai][bj][m][0] * 0.125f, x1 = acc[ai][bj][m][1] * 0.125f;
                        u32x4 w; w.x = cvt_pk_bf16(x0[0], x0[1]); w.y = cvt_pk_bf16(x0[2], x0[3]); w.z = cvt_pk_bf16(x1[0], x1[1]); w.w = cvt_pk_bf16(x1[2], x1[3]);
                        *(u32x4*)(rowp + bj * HALF) = w; } }
        } else if (u.pn < 8) {
#pragma unroll
            for (int ai = 0; ai < 2; ++ai)
#pragma unroll
                for (int m = 0; m < 4; ++m) { const int row = row0 + ai * HALF + m * 16;
                    int b, s, L; size_t kb;
                    if (prompt) { b = row >> 8; s = row & 255; L = LP; kb = BK_OFF; } else { b = (row - NPTOK) >> 10; s = (row - NPTOK) & 1023; L = LSQ; kb = BK_OFF + (size_t)NPTOK * D; }
#pragma unroll
                    for (int bj = 0; bj < 2; ++bj) { const int c = col0 + bj * HALF - 1024, hh = c >> 6, dd = c & 63; const f32x4 x0 = acc[ai][bj][m][0], x1 = acc[ai][bj][m][1];
                        u32x4 w; w.x = cvt_pk_bf16(x0[0], x0[1]); w.y = cvt_pk_bf16(x0[2], x0[3]); w.z = cvt_pk_bf16(x1[0], x1[1]); w.w = cvt_pk_bf16(x1[2], x1[3]);
                        *(u32x4*)(B + kb + ((size_t)((b * NH + hh) * L + s)) * HD + dd) = w;
                        if (prompt) { float* nk = newk + ((size_t)((b * NH + hh) * LP + s)) * HD + dd; *(f32x4*)nk = x0; *(f32x4*)(nk + 4) = x1; } } }
        } else {
            const bool odd = (fr & 1) != 0;
#pragma unroll
            for (int ai = 0; ai < 2; ++ai)
#pragma unroll
                for (int m = 0; m < 4; ++m) { const int row = row0 + ai * HALF + m * 16;
                    int b, s, P; size_t vb;
                    if (prompt) { b = row >> 8; s = row & 255; P = VPP; vb = BV_OFF; } else { b = (row - NPTOK) >> 10; s = (row - NPTOK) & 1023; P = VPS; vb = BVS_OFF; }
#pragma unroll
                    for (int bj = 0; bj < 2; ++bj)
#pragma unroll
                        for (int n = 0; n < 2; ++n) { const int c = col0 + bj * HALF + 4 * n - 2048, hh = c >> 6, dd = c & 63; const f32x4 x = acc[ai][bj][m][n];
                            f32x4 y;
#pragma unroll
                            for (int e = 0; e < 4; ++e) y[e] = __shfl_xor(x[e], 1);
                            const unsigned w0 = odd ? cvt_pk_bf16(y[1], x[1]) : cvt_pk_bf16(x[0], y[0]);
                            const unsigned w1 = odd ? cvt_pk_bf16(y[3], x[3]) : cvt_pk_bf16(x[2], y[2]);
                            bf16_t* vq = B + vb + ((size_t)((b * NH + hh) * HD + dd + (odd ? 1 : 0))) * P + (s & ~1);
                            *(unsigned*)vq = w0; *(unsigned*)(vq + 2 * P) = w1;
                            if (prompt) *(f32x4*)(newv + ((size_t)((b * NH + hh) * LP + s)) * HD + dd) = x; } }
        }
    }
};
}


#define XB_TMO      128
#define XB_XCNT(j)  (256  + 64 * (j))
#define XB_XSUB(j)  (1280 + 64 * (j))
#define XB_XGEN(j)  (2304 + 64 * (j))
#define XB_TOP      3328
#define XB_TOPGEN   3392
#define XCD_BAR_WORDS 3456
#define XB_LSUB(j)  (3456 + 16 * (j))
#define XB_LGEN(j)  (3712 + 16 * (j))
#define XB_ALL_WORDS 4096
#define XB_SPIN_CAP (1u << 18)
__device__ __forceinline__ unsigned xb_ld(unsigned* p)              { return __hip_atomic_load(p, __ATOMIC_RELAXED, __HIP_MEMORY_SCOPE_AGENT); }
__device__ __forceinline__ unsigned xb_add(unsigned* p, unsigned v) { return __hip_atomic_fetch_add(p, v, __ATOMIC_RELAXED, __HIP_MEMORY_SCOPE_AGENT); }
__device__ __forceinline__ unsigned xb_xcc_id() { return (unsigned)__builtin_amdgcn_s_getreg((3 << 11) | 20) & 0xFu; }
#define XB_SPIN(cond, bar) do { unsigned _sp = 0; while (cond) { __builtin_amdgcn_s_sleep(1); \
    if ((++_sp & 255u) == 0u) { if (xb_ld(&(bar)[XB_TMO])) break; if (_sp > XB_SPIN_CAP) { atomicAdd(&(bar)[XB_TMO], 1u); break; } } } } while (0)
struct XcdBarrier { unsigned* bar; unsigned x; volatile LAS unsigned* st; };
__device__ __forceinline__ XcdBarrier xcd_barrier_post(unsigned* bar, volatile LAS unsigned* st) {
    XcdBarrier b; b.bar = bar; b.x = xb_xcc_id(); b.st = st;
    if (opaque_tid() == 0) st[3] = xb_add(&bar[XB_XCNT(b.x)], 1u);
    return b;
}
__device__ __forceinline__ void xcd_barrier_complete(unsigned* bar, unsigned x, unsigned& nloc, unsigned& nx) {
    const unsigned G = gridDim.x * gridDim.y * gridDim.z;
    unsigned sum, cnt, mine, sp = 0u;
    for (;;) {
        sum = 0u; cnt = 0u; mine = 0u;
#pragma unroll
        for (unsigned j = 0; j < 16; ++j) { const unsigned c = xb_ld(&bar[XB_XCNT(j)]); sum += c; cnt += (c > 0u) ? 1u : 0u; mine = (j == x) ? c : mine; }
        if (sum == G) break;
        __builtin_amdgcn_s_sleep(1);
        if ((++sp & 255u) == 0u) { if (xb_ld(&bar[XB_TMO])) break; if (sp > XB_SPIN_CAP) { atomicAdd(&bar[XB_TMO], 1u); break; } }
    }
    nloc = mine > 0u ? mine : 1u; nx = cnt > 0u ? cnt : 1u;
}
__device__ __forceinline__ unsigned xcd_census_uniform(unsigned* bar) {
    unsigned ok = (gridDim.x == 256u) ? 1u : 0u;
#pragma unroll
    for (unsigned j = 0; j < 16; ++j) { const unsigned c = xb_ld(&bar[XB_XCNT(j)]); if (c != (j < 8u ? 32u : 0u)) ok = 0u; }
    return ok;
}
__device__ __forceinline__ void xcd_barrier(const XcdBarrier& b) {
    asm volatile("s_waitcnt vmcnt(0)" ::: "memory");
    __syncthreads();
    if (opaque_tid() == 0) {
        unsigned* bar = b.bar;
        __builtin_amdgcn_s_waitcnt(0);
        unsigned nloc = b.st[0], nx = b.st[1];
        if (nloc == 0u) { xcd_barrier_complete(bar, b.x, nloc, nx); b.st[0] = nloc; b.st[1] = nx; b.st[2] = xcd_census_uniform(bar); }
        const unsigned old = xb_add(&bar[XB_XSUB(b.x)], 1u);
        const unsigned gen = old / nloc;
        if (old + 1u == (gen + 1u) * nloc) {
            __builtin_amdgcn_fence(__ATOMIC_RELEASE, "agent");
            asm volatile("s_waitcnt vmcnt(0)" ::: "memory");
            const unsigned og = xb_add(&bar[XB_TOP], 1u);
            const unsigned tg = og / nx;
            if (og + 1u == (tg + 1u) * nx) xb_add(&bar[XB_TOPGEN], 1u);
            else XB_SPIN(xb_ld(&bar[XB_TOPGEN]) == tg, bar);
            __builtin_amdgcn_fence(__ATOMIC_ACQUIRE, "agent");
            xb_add(&bar[XB_XGEN(b.x)], 1u);
            asm volatile("s_waitcnt vmcnt(0)" ::: "memory");
        } else {
            XB_SPIN(xb_ld(&bar[XB_XGEN(b.x)]) == gen, bar);
            __builtin_amdgcn_fence(__ATOMIC_ACQUIRE, "agent");
            asm volatile("s_waitcnt vmcnt(0)" ::: "memory");
        }
    }
    __syncthreads();
}
__device__ __forceinline__ void xcd_local_barrier(const XcdBarrier& b) {
    asm volatile("s_waitcnt vmcnt(0)" ::: "memory");
    __syncthreads();
    if (opaque_tid() == 0) {
        unsigned* bar = b.bar;
        __builtin_amdgcn_s_waitcnt(0);
        const unsigned nloc = b.st[0];
        const unsigned old = xb_add(&bar[XB_LSUB(b.x)], 1u);
        const unsigned gen = old / nloc;
        if (old + 1u == (gen + 1u) * nloc) xb_add(&bar[XB_LGEN(b.x)], 1u);
        else XB_SPIN(xb_ld(&bar[XB_LGEN(b.x)]) == gen, bar);
        __builtin_amdgcn_fence(__ATOMIC_ACQUIRE, "agent");
        asm volatile("s_waitcnt vmcnt(0)" ::: "memory");
    }
    __syncthreads();
}

struct Args { const float* in[29]; float* out; unsigned char* ws; };

__device__ __forceinline__ void transpose_item(const float* __restrict__ W, int K, int N, bf16_t* WT, int mode, LAS float* scr, int item, int lane) {
    const int nblk = N / 32, kb = item / nblk, nb = item % nblk, k0 = 64 * kb, r0 = 32 * nb;
    const int n_ = lane & 31;
    const int rho_ = r0 + n_, T_ = rho_ >> 8, w_ = rho_ & 255;
    const int srccol = (mode == 0) ? rho_ : ((w_ < 128) ? (128 * T_ + w_) : (DFF + 128 * T_ + w_ - 128));
    float tv[32];
#pragma unroll
    for (int i = 0; i < 32; ++i) { const int kk = 2 * i + (lane >> 5); tv[i] = W[(size_t)(k0 + kk) * N + srccol]; }
#pragma unroll
    for (int i = 0; i < 32; ++i) { const int kk = 2 * i + (lane >> 5); scr[kk * 33 + n_] = tv[i]; }
    asm volatile("s_waitcnt lgkmcnt(0)" ::: "memory");
    const int c = lane & 7;
#pragma unroll
    for (int j = 0; j < 4; ++j) { const int n = (lane >> 3) + 8 * j; const LAS float* s = scr + (8 * c) * 33 + n;
        u32x4 o; o.x = cvt_pk_bf16(s[0 * 33], s[1 * 33]); o.y = cvt_pk_bf16(s[2 * 33], s[3 * 33]); o.z = cvt_pk_bf16(s[4 * 33], s[5 * 33]); o.w = cvt_pk_bf16(s[6 * 33], s[7 * 33]);
        *(u32x4*)(WT + (size_t)(r0 + n) * K + k0 + 8 * c) = o; }
    asm volatile("s_waitcnt lgkmcnt(0)" ::: "memory");
}

constexpr int TI0 = 1536, TI1 = 512, TI2 = 1536, TI3 = 512, TI4 = 2816, TI6 = 1408;
constexpr int TR_P0_END = TI0 + TI1;
constexpr int TR_S2_BEG = TR_P0_END, TR_S2_END = TR_S2_BEG + TI2 + TI3;
constexpr int TR_S1_BEG = TR_S2_END, TR_S1_END = TR_S1_BEG + TI4 + TI6;
constexpr int TR_S3_BEG = TR_S1_END, TR_S3_END = TR_S3_BEG + TI4 + TI6;
__device__ __forceinline__ void transpose_dispatch(const Args& a, LAS float* scr, int r, int lane) {
    if (r < TI0) { transpose_item(a.in[14], 1024, 3072, (bf16_t*)(a.ws + WS_WHYIN), 0, scr, r, lane); return; } r -= TI0;
    if (r < TI1) { transpose_item(a.in[25], 1024, 1024, (bf16_t*)(a.ws + WS_WHYOUT), 0, scr, r, lane); return; } r -= TI1;
    if (r < TI2) { transpose_item(a.in[26], 1024, 3072, (bf16_t*)(a.ws + WS_WQKV), 0, scr, r, lane); return; } r -= TI2;
    if (r < TI3) { transpose_item(a.in[28], 1024, 1024, (bf16_t*)(a.ws + WS_WNAOUT), 0, scr, r, lane); return; } r -= TI3;
    if (r < TI4) { transpose_item(a.in[12], 1024, 5632, (bf16_t*)(a.ws + WS_WFFIN), 1, scr, r, lane); return; } r -= TI4;
    if (r < TI6) { transpose_item(a.in[13], DFF, 1024, (bf16_t*)(a.ws + WS_WFFOUT), 0, scr, r, lane); return; } r -= TI6;
    if (r < TI4) { transpose_item(a.in[12] + (size_t)1024 * 5632, 1024, 5632, (bf16_t*)(a.ws + WS_WFFIN) + (size_t)5632 * 1024, 1, scr, r, lane); return; } r -= TI4;
    transpose_item(a.in[13] + (size_t)DFF * 1024, DFF, 1024, (bf16_t*)(a.ws + WS_WFFOUT) + (size_t)1024 * DFF, 0, scr, r, lane);
}
__device__ __forceinline__ void deferred_transposes(const Args& a, LAS unsigned char* lds, int r0, int r1, int slot, int nslots) {
    const int lane = opaque_tid() & 63, wave = opaque_tid() >> 6;
    LAS float* scr = (LAS float*)(lds + wave * 16384);
    for (int r = r0 + slot * 8 + wave; r < r1; r += nslots * 8) transpose_dispatch(a, scr, r, lane);
    __syncthreads();
}

__device__ __forceinline__ void ada_item(const Args& a, LAS unsigned char* lds, int it) {
    const int tid = opaque_tid();
    const int layer = it / 96, n0 = 64 * (it % 96);
    LAS float* sl = (LAS float*)lds;
    LAS float* part = (LAS float*)(lds + 20480);
    const float* cs = a.in[4]; const float* cctx = a.in[5];
    for (int i = tid; i < 5 * 1024; i += NTHR) { const int v = i >> 10, k = i & 1023; const float x = (v == 0) ? cctx[k] : cs[(v - 1) * 1024 + k]; sl[i] = x / (1.0f + expf(-x)); }
    __syncthreads();
    const int ln = tid & 15, kg = tid >> 4;
    const float* w = a.in[6] + ((size_t)layer * 1024 + kg * 32) * 6144 + n0 + 4 * ln;
    f32x4 acc[5];
#pragma unroll
    for (int v = 0; v < 5; ++v) acc[v] = (f32x4){0.f, 0.f, 0.f, 0.f};
#pragma unroll 16
    for (int kk = 0; kk < 32; ++kk) { const f32x4 wv = *(const f32x4*)(w + (size_t)kk * 6144); const int k = kg * 32 + kk;
#pragma unroll
        for (int v = 0; v < 5; ++v) acc[v] += wv * sl[v * 1024 + k]; }
#pragma unroll
    for (int v = 0; v < 5; ++v) *(LAS f32x4*)(part + (kg * 5 + v) * 64 + 4 * ln) = acc[v];
    __syncthreads();
    if (tid < 320) { const int v = tid >> 6, n = tid & 63; float s = a.in[7][layer * 6144 + n0 + n];
        for (int g = 0; g < 32; ++g) s += part[(g * 5 + v) * 64 + n];
        __hip_atomic_store((float*)(a.ws + WS_ADA) + (layer * 5 + v) * 6144 + n0 + n, s, __ATOMIC_RELAXED, __HIP_MEMORY_SCOPE_AGENT); }
    asm volatile("s_waitcnt vmcnt(0)" ::: "memory");
    __syncthreads();
    if (tid == 0 && it < 32) (void)__hip_atomic_fetch_add((unsigned*)(a.ws + WS_BAR) + 1, 1u, __ATOMIC_RELAXED, __HIP_MEMORY_SCOPE_AGENT);
}

__device__ __forceinline__ void filter_item(const Args& a, LAS unsigned char* lds, int it) {
    const int tid = opaque_tid(), lane = tid & 63, wave = tid >> 6;
    int L, pg; bf16_t* R;
    if (it < 32) { L = 256; pg = it; R = (bf16_t*)(a.ws + WS_RF256); } else { L = 1024; pg = it - 32; R = (bf16_t*)(a.ws + WS_RF1024); }
    LAS float* H2 = (LAS float*)lds;
    LAS float* fs = (LAS float*)(lds + 4096) + wave * 128;
    const float* w1 = a.in[17]; const float* b1 = a.in[18]; const float* w2 = a.in[19]; const float* b2 = a.in[20]; const float* w3 = a.in[21];
    const float* fq = a.in[22]; const float* dec = a.in[23]; const float* hb = a.in[24];
    LAS float* w1s = (LAS float*)(lds + 8192);
    LAS float* w2s = (LAS float*)(lds + 8192 + 8448);
    { float t1[5], t2[8];
#pragma unroll
      for (int k = 0; k < 5; ++k) { const int i = tid + k * NTHR; t1[k] = (i < 33 * 64) ? w1[i] : 0.f; }
#pragma unroll
      for (int k = 0; k < 8; ++k) t2[k] = w2[tid + k * NTHR];
#pragma unroll
      for (int k = 0; k < 5; ++k) { const int i = tid + k * NTHR; if (i < 33 * 64) w1s[i] = t1[k]; }
#pragma unroll
      for (int k = 0; k < 8; ++k) w2s[tid + k * NTHR] = t2[k]; }
    __syncthreads();
    {
        const int pl = wave, pos = pg * 8 + pl;
        const float tn = (float)pos / (float)(L - 1);
        const float wang = (6.283185307179586f / (float)L) * (float)pos;
        if (lane < 33) { float f;
            if (lane == 0) f = tn;
            else { const int kb = (lane - 1) & 15; const float band = 1e-4f + (float)kb * ((15.0f - 1e-4f) / 15.0f); const float arg = band * wang; f = (lane <= 16) ? cosf(arg) : sinf(arg); }
            fs[lane] = f; }
        asm volatile("s_waitcnt lgkmcnt(0)" ::: "memory");
        float s = b1[lane];
#pragma unroll 11
        for (int e = 0; e < 33; ++e) s += fs[e] * w1s[e * 64 + lane];
        fs[64 + lane] = sinf(fq[lane] * s);
        asm volatile("s_waitcnt lgkmcnt(0)" ::: "memory");
        float s2 = b2[lane];
#pragma unroll 16
        for (int e = 0; e < 64; ++e) s2 += fs[64 + e] * w2s[e * 64 + lane];
        H2[pl * 64 + lane] = sinf(fq[64 + lane] * s2);
        asm volatile("s_waitcnt lgkmcnt(0)" ::: "memory");
    }
    __syncthreads();
    const f32x4 dc = *(const f32x4*)(dec + 4 * tid);
    {
        f32x4 acc[8];
#pragma unroll
        for (int p = 0; p < 8; ++p) acc[p] = (f32x4){0.f, 0.f, 0.f, 0.f};
#pragma unroll 16
        for (int e = 0; e < 64; ++e) { const f32x4 wv = *(const f32x4*)(w3 + (size_t)e * 2048 + 4 * tid);
#pragma unroll
            for (int p = 0; p < 8; ++p) acc[p] += wv * H2[p * 64 + e]; }
#pragma unroll
        for (int cc = 0; cc < 4; ++cc) { const int c = 4 * tid + cc; const float ad = fabsf(dc[cc]);
            float v8[8];
#pragma unroll
            for (int p = 0; p < 8; ++p) { const float tn = (float)(pg * 8 + p) / (float)(L - 1); v8[p] = acc[p][cc] * (__expf(-tn * ad) + 0.05f); }
            if (c < D) {
                if (pg == 0) v8[0] += hb[c];
                u32x4 w; w.x = cvt_pk_bf16(v8[7], v8[6]); w.y = cvt_pk_bf16(v8[5], v8[4]); w.z = cvt_pk_bf16(v8[3], v8[2]); w.w = cvt_pk_bf16(v8[1], v8[0]);
                *(u32x4*)(R + (size_t)c * 2 * L + L - 8 * (pg + 1)) = w;
            } else {
                bf16_t* row = R + (size_t)(c - D) * 2 * L; const int m0 = L - 1 + 8 * pg;
                if (pg == 0) row[2 * L - 1] = 0; else row[m0] = f2bf(v8[0]);
                *(unsigned*)(row + m0 + 1) = cvt_pk_bf16(v8[1], v8[2]); *(unsigned*)(row + m0 + 3) = cvt_pk_bf16(v8[3], v8[4]); *(unsigned*)(row + m0 + 5) = cvt_pk_bf16(v8[5], v8[6]);
                row[m0 + 7] = f2bf(v8[7]);
            }
        }
    }
    __syncthreads();
}

__device__ __forceinline__ void e1_item(const Args& a, int e) {
    const int tid = opaque_tid(), lane = tid & 63, wave = tid >> 6;
    if (tid == 0) { unsigned* done = (unsigned*)(a.ws + WS_BAR) + 1; unsigned sp = 0u;
        while (__hip_atomic_load(done, __ATOMIC_RELAXED, __HIP_MEMORY_SCOPE_AGENT) < 32u) { __builtin_amdgcn_s_sleep(2); if (++sp > (1u << 20)) break; }
        __builtin_amdgcn_fence(__ATOMIC_ACQUIRE, "agent");
        asm volatile("s_waitcnt vmcnt(0)" ::: "memory"); }
    __syncthreads();
    const float* ada = (const float*)(a.ws + WS_ADA);
    bf16_t* H = (bf16_t*)(a.ws + WS_H);
#pragma unroll
    for (int i = 0; i < 4; ++i) { const int row = 32 * e + 4 * wave + i;
        const float* src = (row < NPTOK) ? a.in[0] + (size_t)row * D : a.in[1] + (size_t)(row - NPTOK) * D;
        const int v = (row < NPTOK) ? 0 : 1 + ((row - NPTOK) >> 10);
        const float* av = ada + v * 6144;
#pragma unroll
        for (int j = 0; j < 4; ++j) { const int col = 4 * lane + 256 * j;
            const f32x4 x = *(const f32x4*)(src + col), sh = *(const f32x4*)(av + col), sc = *(const f32x4*)(av + 1024 + col);
            const f32x4 y = x * (sc + 1.0f) + sh; u32x2 w; w.x = cvt_pk_bf16(y[0], y[1]); w.y = cvt_pk_bf16(y[2], y[3]);
            *(u32x2*)(H + (size_t)row * D + col) = w; } }
}

__device__ __forceinline__ void p0_prep(const Args& a, LAS unsigned char* lds) {
    const int tid = opaque_tid(), lane = tid & 63, wave = tid >> 6, bx = blockIdx.x, G = gridDim.x;
    LAS float* scr = (LAS float*)(lds + wave * 16384);
    constexpr int NIT = TR_P0_END, NCHUNK = NIT / 8, NE1 = NTOK / 32, NFILT = 160, NPRE = NFILT + 192, NITEMS = NPRE + NCHUNK + NE1;
    static_assert(NIT % 8 == 0, "transpose items in chunks of 8");
    unsigned* ctr = (unsigned*)(a.ws + WS_BAR);
    volatile LAS int* nxt = (volatile LAS int*)(lds + LDS_CTL + 128);
    for (;;) {
        __syncthreads();
        if (tid == 0) *nxt = (int)__hip_atomic_fetch_add(ctr, 1u, __ATOMIC_RELAXED, __HIP_MEMORY_SCOPE_AGENT);
        __syncthreads();
        const int item = *nxt;
        if (item >= NITEMS) break;
        if (item < NFILT) { filter_item(a, lds, item); continue; }
        if (item < NPRE) { ada_item(a, lds, item - NFILT); continue; }
        if (item >= NPRE + NCHUNK) { e1_item(a, item - NPRE - NCHUNK); continue; }
        transpose_dispatch(a, scr, (item - NPRE) * 8 + wave, lane);
    }
    __syncthreads();
}

__device__ __forceinline__ void e1_modulate(const Args& a) {
    const int lane = opaque_tid() & 63, gw = blockIdx.x * NWAVES + (opaque_tid() >> 6), NGW = gridDim.x * NWAVES;
    const float* ada = (const float*)(a.ws + WS_ADA);
    bf16_t* H = (bf16_t*)(a.ws + WS_H);
    for (int row = gw; row < NTOK; row += NGW) {
        const float* src = (row < NPTOK) ? a.in[0] + (size_t)row * D : a.in[1] + (size_t)(row - NPTOK) * D;
        const int v = (row < NPTOK) ? 0 : 1 + ((row - NPTOK) >> 10);
        const float* av = ada + v * 6144;
#pragma unroll
        for (int j = 0; j < 4; ++j) { const int col = 4 * lane + 256 * j;
            const f32x4 x = *(const f32x4*)(src + col), sh = *(const f32x4*)(av + col), sc = *(const f32x4*)(av + 1024 + col);
            const f32x4 y = x * (sc + 1.0f) + sh; u32x2 w; w.x = cvt_pk_bf16(y[0], y[1]); w.y = cvt_pk_bf16(y[2], y[3]);
            *(u32x2*)(H + (size_t)row * D + col) = w; }
    }
}
template <bool FINAL> __device__ __forceinline__ void ln_rows4(const Args& a, const float* lng, const float* lnb, float* xout, const float* adav, int rowbase, const float* bpf, const float* bsf);
template <bool FINAL>
__device__ __forceinline__ void ln_phase(const Args& a, const float* lng, const float* lnb, float* xout, const float* adav  , int vb = -1, const float* bpf = nullptr, const float* bsf = nullptr) {
    if (vb >= 0) { ln_rows4<FINAL>(a, lng, lnb, xout, adav, 1024 * (vb & 7) + 32 * (vb >> 3) + 4 * (opaque_tid() >> 6), bpf, bsf); return; }
    const int lane = opaque_tid() & 63, wv = opaque_tid() >> 6;
    const int gw = (vb >= 0) ? (1024 * (vb & 7) + 32 * (vb >> 3) + 4 * wv) : (int)(blockIdx.x * NWAVES + wv), NGW = (vb >= 0) ? 1 : (int)(gridDim.x * NWAVES);
    const int rend = (vb >= 0) ? gw + 4 : NTOK;
    const bf16_t* P0 = (const bf16_t*)(a.ws + WS_P0); const bf16_t* P1 = (const bf16_t*)(a.ws + WS_P1);
    bf16_t* H = (bf16_t*)(a.ws + WS_H); bf16_t* X = (bf16_t*)(a.ws + WS_X);
    for (int row = gw; row < rend; row += NGW) {
        float v[16]; float s = 0.f;
#pragma unroll
        for (int j = 0; j < 2; ++j) { const int col = 8 * lane + 512 * j;
            const u32x4 p = *(const u32x4*)(P0 + (size_t)row * D + col), q = *(const u32x4*)(P1 + (size_t)row * D + col);
            v[8 * j + 0] = bflo(p.x) + bflo(q.x); v[8 * j + 1] = bfhi(p.x) + bfhi(q.x); v[8 * j + 2] = bflo(p.y) + bflo(q.y); v[8 * j + 3] = bfhi(p.y) + bfhi(q.y);
            v[8 * j + 4] = bflo(p.z) + bflo(q.z); v[8 * j + 5] = bfhi(p.z) + bfhi(q.z); v[8 * j + 6] = bflo(p.w) + bflo(q.w); v[8 * j + 7] = bfhi(p.w) + bfhi(q.w);
            if (bpf) { const float* br = ((row < NPTOK) ? bpf + (size_t)row * D : bsf + (size_t)(row - NPTOK) * D) + col; const f32x4 b0 = *(const f32x4*)br, b1 = *(const f32x4*)(br + 4);
#pragma unroll
                for (int e = 0; e < 4; ++e) { v[8 * j + e] += ALPHA_C * b0[e]; v[8 * j + 4 + e] += ALPHA_C * b1[e]; } }
            else { const u32x4 xb = *(const u32x4*)((const bf16_t*)(a.ws + WS_X) + (size_t)row * D + col);
                v[8 * j + 0] += ALPHA_C * bflo(xb.x); v[8 * j + 1] += ALPHA_C * bfhi(xb.x); v[8 * j + 2] += ALPHA_C * bflo(xb.y); v[8 * j + 3] += ALPHA_C * bfhi(xb.y);
                v[8 * j + 4] += ALPHA_C * bflo(xb.z); v[8 * j + 5] += ALPHA_C * bfhi(xb.z); v[8 * j + 6] += ALPHA_C * bflo(xb.w); v[8 * j + 7] += ALPHA_C * bfhi(xb.w); } }
#pragma unroll
        for (int e = 0; e < 16; ++e) s += v[e];
        const float mean = wave_sum(s) * (1.0f / D); float s2 = 0.f;
#pragma unroll
        for (int e = 0; e < 16; ++e) { v[e] -= mean; s2 += v[e] * v[e]; }
        const float rstd = 1.0f / sqrtf(wave_sum(s2) * (1.0f / D) + LN_EPS_C);
        const int vi = (row < NPTOK) ? 0 : 1 + ((row - NPTOK) >> 10);
#pragma unroll
        for (int j = 0; j < 2; ++j) { const int col = 8 * lane + 512 * j;
            const f32x4 g0 = *(const f32x4*)(lng + col), g1 = *(const f32x4*)(lng + col + 4), b0 = *(const f32x4*)(lnb + col), b1 = *(const f32x4*)(lnb + col + 4);
            f32x4 y0, y1;
#pragma unroll
            for (int e = 0; e < 4; ++e) { y0[e] = v[8 * j + e] * rstd * g0[e] + b0[e]; y1[e] = v[8 * j + 4 + e] * rstd * g1[e] + b1[e]; }
            if (FINAL) { *(f32x4*)(xout + (size_t)row * D + col) = y0; *(f32x4*)(xout + (size_t)row * D + col + 4) = y1; }
            else {
                u32x4 w; w.x = cvt_pk_bf16(y0[0], y0[1]); w.y = cvt_pk_bf16(y0[2], y0[3]); w.z = cvt_pk_bf16(y1[0], y1[1]); w.w = cvt_pk_bf16(y1[2], y1[3]);
                *(u32x4*)(X + (size_t)row * D + col) = w;
                const float* ap = adav + vi * 6144 + col;
                const f32x4 sh0 = *(const f32x4*)(ap), sh1 = *(const f32x4*)(ap + 4), sc0 = *(const f32x4*)(ap + 1024), sc1 = *(const f32x4*)(ap + 1028);
                const f32x4 h0 = y0 * (sc0 + 1.0f) + sh0, h1 = y1 * (sc1 + 1.0f) + sh1;
                u32x4 hw; hw.x = cvt_pk_bf16(h0[0], h0[1]); hw.y = cvt_pk_bf16(h0[2], h0[3]); hw.z = cvt_pk_bf16(h1[0], h1[1]); hw.w = cvt_pk_bf16(h1[2], h1[3]);
                *(u32x4*)(H + (size_t)row * D + col) = hw; }
        }
    }
}


template <bool FINAL>
__device__ __forceinline__ void ln_rows4(const Args& a, const float* lng, const float* lnb, float* xout, const float* adav, int rowbase, const float* bpf, const float* bsf) {
    const int lane = opaque_tid() & 63;
    const bf16_t* P0 = (const bf16_t*)(a.ws + WS_P0); const bf16_t* P1 = (const bf16_t*)(a.ws + WS_P1);
    bf16_t* H = (bf16_t*)(a.ws + WS_H); bf16_t* X = (bf16_t*)(a.ws + WS_X);
    constexpr int RB = 4;
    float v[RB][16]; float mean[RB], rstd[RB];
    const int vi = (rowbase < NPTOK) ? 0 : 1 + ((rowbase - NPTOK) >> 10);
    f32x4 pg[2][2], pb[2][2], psh[2][2], psc[2][2];
#pragma unroll
    for (int j = 0; j < 2; ++j) { const int col = 8 * lane + 512 * j;
        pg[j][0] = *(const f32x4*)(lng + col); pg[j][1] = *(const f32x4*)(lng + col + 4); pb[j][0] = *(const f32x4*)(lnb + col); pb[j][1] = *(const f32x4*)(lnb + col + 4);
        if (!FINAL) { const float* ap = adav + vi * 6144 + col; psh[j][0] = *(const f32x4*)(ap); psh[j][1] = *(const f32x4*)(ap + 4); psc[j][0] = *(const f32x4*)(ap + 1024); psc[j][1] = *(const f32x4*)(ap + 1028); } }
#pragma unroll
    for (int rr = 0; rr < RB; ++rr) { const int row = rowbase + rr;
#pragma unroll
        for (int j = 0; j < 2; ++j) { const int col = 8 * lane + 512 * j;
            const u32x4 p = *(const u32x4*)(P0 + (size_t)row * D + col), q = *(const u32x4*)(P1 + (size_t)row * D + col);
            v[rr][8 * j + 0] = bflo(p.x) + bflo(q.x); v[rr][8 * j + 1] = bfhi(p.x) + bfhi(q.x); v[rr][8 * j + 2] = bflo(p.y) + bflo(q.y); v[rr][8 * j + 3] = bfhi(p.y) + bfhi(q.y);
            v[rr][8 * j + 4] = bflo(p.z) + bflo(q.z); v[rr][8 * j + 5] = bfhi(p.z) + bfhi(q.z); v[rr][8 * j + 6] = bflo(p.w) + bflo(q.w); v[rr][8 * j + 7] = bfhi(p.w) + bfhi(q.w);
            if (bpf) { const float* br = ((row < NPTOK) ? bpf + (size_t)row * D : bsf + (size_t)(row - NPTOK) * D) + col; const f32x4 b0 = *(const f32x4*)br, b1 = *(const f32x4*)(br + 4);
#pragma unroll
                for (int e = 0; e < 4; ++e) { v[rr][8 * j + e] += ALPHA_C * b0[e]; v[rr][8 * j + 4 + e] += ALPHA_C * b1[e]; } }
            else { const u32x4 xb = *(const u32x4*)(X + (size_t)row * D + col);
                v[rr][8 * j + 0] += ALPHA_C * bflo(xb.x); v[rr][8 * j + 1] += ALPHA_C * bfhi(xb.x); v[rr][8 * j + 2] += ALPHA_C * bflo(xb.y); v[rr][8 * j + 3] += ALPHA_C * bfhi(xb.y);
                v[rr][8 * j + 4] += ALPHA_C * bflo(xb.z); v[rr][8 * j + 5] += ALPHA_C * bfhi(xb.z); v[rr][8 * j + 6] += ALPHA_C * bflo(xb.w); v[rr][8 * j + 7] += ALPHA_C * bfhi(xb.w); } } }
#pragma unroll
    for (int rr = 0; rr < RB; ++rr) { float s = 0.f;
#pragma unroll
        for (int e = 0; e < 16; ++e) s += v[rr][e];
        mean[rr] = s; }
#pragma unroll
    for (int o = 1; o < 64; o <<= 1)
#pragma unroll
        for (int rr = 0; rr < RB; ++rr) mean[rr] += __shfl_xor(mean[rr], o);
#pragma unroll
    for (int rr = 0; rr < RB; ++rr) { mean[rr] *= (1.0f / D); float s2 = 0.f;
#pragma unroll
        for (int e = 0; e < 16; ++e) { v[rr][e] -= mean[rr]; s2 += v[rr][e] * v[rr][e]; }
        rstd[rr] = s2; }
#pragma unroll
    for (int o = 1; o < 64; o <<= 1)
#pragma unroll
        for (int rr = 0; rr < RB; ++rr) rstd[rr] += __shfl_xor(rstd[rr], o);
#pragma unroll
    for (int rr = 0; rr < RB; ++rr) { const int row = rowbase + rr;
        const float rs = 1.0f / sqrtf(rstd[rr] * (1.0f / D) + LN_EPS_C);
#pragma unroll
        for (int j = 0; j < 2; ++j) { const int col = 8 * lane + 512 * j;
            const f32x4 g0 = pg[j][0], g1 = pg[j][1], b0 = pb[j][0], b1 = pb[j][1];
            f32x4 y0, y1;
#pragma unroll
            for (int e = 0; e < 4; ++e) { y0[e] = v[rr][8 * j + e] * rs * g0[e] + b0[e]; y1[e] = v[rr][8 * j + 4 + e] * rs * g1[e] + b1[e]; }
            if (FINAL) { *(f32x4*)(xout + (size_t)row * D + col) = y0; *(f32x4*)(xout + (size_t)row * D + col + 4) = y1; }
            else {
                u32x4 w; w.x = cvt_pk_bf16(y0[0], y0[1]); w.y = cvt_pk_bf16(y0[2], y0[3]); w.z = cvt_pk_bf16(y1[0], y1[1]); w.w = cvt_pk_bf16(y1[2], y1[3]);
                *(u32x4*)(X + (size_t)row * D + col) = w;
                const f32x4 sh0 = psh[j][0], sh1 = psh[j][1], sc0 = psc[j][0], sc1 = psc[j][1];
                const f32x4 h0 = y0 * (sc0 + 1.0f) + sh0, h1 = y1 * (sc1 + 1.0f) + sh1;
                u32x4 hw; hw.x = cvt_pk_bf16(h0[0], h0[1]); hw.y = cvt_pk_bf16(h0[2], h0[3]); hw.z = cvt_pk_bf16(h1[0], h1[1]); hw.w = cvt_pk_bf16(h1[2], h1[3]);
                *(u32x4*)(H + (size_t)row * D + col) = hw; }
        }
    }
}

__device__ __forceinline__ void conv3_chunk(const bf16_t* zrow, int s0, int L, float w0, float w1, float w2, float bb, float (&o)[8]) {
    const u32x4 q = *(const u32x4*)(zrow + s0);
    float z[10];
    z[1] = bflo(q.x); z[2] = bfhi(q.x); z[3] = bflo(q.y); z[4] = bfhi(q.y); z[5] = bflo(q.z); z[6] = bfhi(q.z); z[7] = bflo(q.w); z[8] = bfhi(q.w);
    z[0] = (s0 > 0) ? bf2f(zrow[s0 - 1]) : 0.f; z[9] = (s0 + 8 < L) ? bf2f(zrow[s0 + 8]) : 0.f;
#pragma unroll
    for (int e = 0; e < 8; ++e) o[e] = z[e] * w0 + z[e + 1] * w1 + z[e + 2] * w2 + bb;
}
__device__ __forceinline__ void conv3_regs(const u32x4 q, bf16_t prev, bf16_t next, float w0, float w1, float w2, float bb, float (&o)[8]) {
    float z[10];
    z[0] = bf2f(prev); z[1] = bflo(q.x); z[2] = bfhi(q.x); z[3] = bflo(q.y); z[4] = bfhi(q.y); z[5] = bflo(q.z); z[6] = bfhi(q.z); z[7] = bflo(q.w); z[8] = bfhi(q.w); z[9] = bf2f(next);
#pragma unroll
    for (int e = 0; e < 8; ++e) o[e] = z[e] * w0 + z[e + 1] * w1 + z[e + 2] * w2 + bb;
}
template <int L, int NBH>
__device__ __forceinline__ void hyena_item(const Args& a, LAS unsigned char* lds, int d0, int tokbase) {
    constexpr int nA = L / 32, BPT = 32 / nA, NT = NBH * nA / 32, NTOKI = NBH * L;
    static_assert(NT == 2 && NTOKI == 2048, "half-item geometry");
    const int tid = opaque_tid(), lane = tid & 63, wave = tid >> 6;
    const int d = d0 + wave;
    const bf16_t* zT = (const bf16_t*)(a.ws + WS_BIG);
    const bf16_t* R = (const bf16_t*)(a.ws + (L == 256 ? WS_RF256 : WS_RF1024)) + (size_t)d * 2 * L;
    LAS unsigned char* Fr = lds + wave * HY_WSTR;
    LAS unsigned char* Vr = Fr + 8192;
    LAS unsigned* cp = (LAS unsigned*)Fr;
    const float* sw = a.in[15]; const float* sb = a.in[16];
    LAS unsigned char* Xr = Fr + 13312;
    for (int hr1_ = 0; hr1_ <= (int)(HYREP & 1u); ++hr1_) {
    { const u32x4* rd4 = (const u32x4*)R; const unsigned* rd = (const unsigned*)R;
      u32x4 fx[L / 256]; unsigned fy[L / 256];
#pragma unroll
      for (int it = 0; it < L / 256; ++it) { const int q4 = lane + 64 * it; fx[it] = rd4[q4]; fy[it] = (4 * q4 + 4 < L) ? rd[4 * q4 + 4] : 0u; }
#pragma unroll
      for (int it = 0; it < L / 256; ++it) { const int q = 4 * (lane + 64 * it); const u32x4 x = fx[it];
          *(LAS u32x4*)(cp + q) = x;
          u32x4 y; y.x = (x.x >> 16) | (x.y << 16); y.y = (x.y >> 16) | (x.z << 16); y.z = (x.z >> 16) | (x.w << 16); y.w = (x.w >> 16) | (fy[it] << 16);
          *(LAS u32x4*)(cp + L + q) = y; } }
    { const float v0 = sw[2048 + d], v1 = sw[3072 + 2048 + d], v2 = sw[6144 + 2048 + d], vb = sb[2048 + d];
      const float x0 = sw[1024 + d], x1 = sw[3072 + 1024 + d], x2 = sw[6144 + 1024 + d], xb = sb[1024 + d];
      const float o0 = sw[d], o1 = sw[3072 + d], o2 = sw[6144 + d], ob = sb[d];
      const bf16_t* zv = zT + (size_t)(2048 + d) * NTOK + tokbase; const bf16_t* zx = zT + (size_t)(1024 + d) * NTOK + tokbase; const bf16_t* zo = zT + (size_t)d * NTOK + tokbase;
      constexpr int NI = NTOKI / 8 / 64;
      u32x4 rv[NI], rx[NI], ro[NI]; bf16_t pv[NI], nv[NI], px[NI], nx[NI], po[NI], no[NI];
#pragma unroll
      for (int it = 0; it < NI; ++it) { const int idx = lane + 64 * it; const int t0 = idx * 8, s0 = t0 % L;
          rv[it] = *(const u32x4*)(zv + t0); rx[it] = *(const u32x4*)(zx + t0); ro[it] = *(const u32x4*)(zo + t0);
          const bool hp = s0 > 0, hn = s0 + 8 < L;
          pv[it] = hp ? zv[t0 - 1] : (bf16_t)0; nv[it] = hn ? zv[t0 + 8] : (bf16_t)0;
          px[it] = hp ? zx[t0 - 1] : (bf16_t)0; nx[it] = hn ? zx[t0 + 8] : (bf16_t)0;
          po[it] = hp ? zo[t0 - 1] : (bf16_t)0; no[it] = hn ? zo[t0 + 8] : (bf16_t)0; }
#pragma unroll
      for (int it = 0; it < NI; ++it) { const int idx = lane + 64 * it; const int t0 = idx * 8;
          float cv[8], cx[8], co[8];
          conv3_regs(rv[it], pv[it], nv[it], v0, v1, v2, vb, cv); conv3_regs(rx[it], px[it], nx[it], x0, x1, x2, xb, cx); conv3_regs(ro[it], po[it], no[it], o0, o1, o2, ob, co);
          u32x4 w; w.x = cvt_pk_bf16(cv[0] * cx[0], cv[1] * cx[1]); w.y = cvt_pk_bf16(cv[2] * cx[2], cv[3] * cx[3]); w.z = cvt_pk_bf16(cv[4] * cx[4], cv[5] * cx[5]); w.w = cvt_pk_bf16(cv[6] * cx[6], cv[7] * cx[7]);
          *(LAS u32x4*)(Vr + (t0 >> 5) * 80 + (t0 & 31) * 2) = w;
          u32x4 wo; wo.x = cvt_pk_bf16(co[0], co[1]); wo.y = cvt_pk_bf16(co[2], co[3]); wo.z = cvt_pk_bf16(co[4], co[5]); wo.w = cvt_pk_bf16(co[6], co[7]);
          *(LAS u32x4*)(Xr + (size_t)t0 * 2) = wo; } }
    __syncthreads(); }
    __syncthreads();
    f32x16 acc[NT];
#pragma unroll
    for (int q = 0; q < NT; ++q)
#pragma unroll
        for (int e = 0; e < 16; ++e) acc[q][e] = 0.f;
    for (int hr2_ = 0; hr2_ <= (int)((HYREP >> 1) & 1u); ++hr2_) {
    if (hr2_ == 1) { _Pragma("unroll") for (int q = 0; q < NT; ++q) _Pragma("unroll") for (int e = 0; e < 16; ++e) acc[q][e] *= 0.5f; }
    {
        const int i = lane & 31, h = lane >> 5, p = 1 - (i & 1);
        const int n = lane & 31, aidx = n % nA, bsub = n / nA;
        LAS const unsigned* cpp = cp + p * L;
        LAS const unsigned char* zero16 = lds + HY_ZERO;
        LAS const unsigned char* vlane = Vr + bsub * nA * 80 + 16 * h;
        const int mbase = (L - 1) - i + 8 * h;
        LAS const unsigned* ap = cpp + (mbase >> 1) + 16 * (nA - 1);
        int ab = aidx + (nA - 1);
        LAS const unsigned char* vr = vlane + ab * 80;
#pragma unroll 1
        for (int it = 0; it < 2 * nA - 1; ++it) {
            const bool ok = (ab >= 0) && (ab < nA);
            LAS const unsigned char* vrow = ok ? vr : zero16;
            const int vstep = ok ? BPT * nA * 80 : 0, jstep = ok ? 32 : 0;
            u32x4 af0, af1; af0.x = ap[0]; af0.y = ap[1]; af0.z = ap[2]; af0.w = ap[3]; af1.x = ap[8]; af1.y = ap[9]; af1.z = ap[10]; af1.w = ap[11];
            u32x4 bf[NT][2];
#pragma unroll
            for (int q = 0; q < NT; ++q) { bf[q][0] = *(LAS const u32x4*)(vrow + q * vstep); bf[q][1] = *(LAS const u32x4*)(vrow + q * vstep + jstep); }
#pragma unroll
            for (int q = 0; q < NT; ++q) {
                acc[q] = __builtin_amdgcn_mfma_f32_32x32x16_bf16(__builtin_bit_cast(bf16x8, af0), __builtin_bit_cast(bf16x8, bf[q][0]), acc[q], 0, 0, 0);
                acc[q] = __builtin_amdgcn_mfma_f32_32x32x16_bf16(__builtin_bit_cast(bf16x8, af1), __builtin_bit_cast(bf16x8, bf[q][1]), acc[q], 0, 0, 0); }
            ap -= 16; ab -= 1; vr -= 80;
        }
    }
    }
    if ((HYREP >> 1) & 1u) { _Pragma("unroll") for (int q = 0; q < NT; ++q) _Pragma("unroll") for (int e = 0; e < 16; ++e) acc[q][e] *= (2.0f / 3.0f); }
    __syncthreads();
    { const int h = lane >> 5, n = lane & 31, aidx = n % nA, bsub = n / nA;
#pragma unroll
      for (int q = 0; q < NT; ++q) { const int b = q * BPT + bsub;
#pragma unroll
          for (int rg = 0; rg < 4; ++rg) { const int t = 32 * aidx + 8 * rg + 4 * h; const int off = (b * L + t) * 2;
              const u32x2 xc = *(LAS const u32x2*)(Xr + off);
              u32x2 w; w.x = cvt_pk_bf16(acc[q][4 * rg] * bflo(xc.x), acc[q][4 * rg + 1] * bfhi(xc.x)); w.y = cvt_pk_bf16(acc[q][4 * rg + 2] * bflo(xc.y), acc[q][4 * rg + 3] * bfhi(xc.y));
              *(LAS u32x2*)(Vr + ((b * L + t) >> 5) * 80 + (t & 31) * 2) = w; } } }
    __syncthreads();
    for (int hr3_ = 0; hr3_ <= (int)((HYREP >> 2) & 1u); ++hr3_)
    { bf16_t* Y = (bf16_t*)(a.ws + WS_Y);
#pragma unroll
      for (int it = 0; it < NTOKI / NTHR; ++it) { const int tok = tid + it * NTHR; unsigned short e[8];
#pragma unroll
          for (int w = 0; w < 8; ++w) e[w] = *(LAS const unsigned short*)(lds + w * HY_WSTR + 8192 + (tok >> 5) * 80 + (tok & 31) * 2);
          u32x4 o; o.x = e[0] | ((unsigned)e[1] << 16); o.y = e[2] | ((unsigned)e[3] << 16); o.z = e[4] | ((unsigned)e[5] << 16); o.w = e[6] | ((unsigned)e[7] << 16);
          *(u32x4*)(Y + (size_t)(tokbase + tok) * D + d0) = o; } }
    __syncthreads();
}

constexpr int AT_KP = 144, AT_VP = 528;
constexpr int AT_K_OFF = 2048, AT_V_OFF = AT_K_OFF + 256 * AT_KP;
constexpr int AT_LVP = 912;
constexpr int AT_LK_OFF = 2048, AT_LV_OFF = 65536;
__device__ __forceinline__ void attn_stage_kv(LAS unsigned char* lds, const char* ksrc, const char* vsrc, int vpitch) {
    const int tid = opaque_tid();
    u32x4 kv[4], vv[4];
#pragma unroll
    for (int k = 0; k < 4; ++k) { const int p = tid + NTHR * k; kv[k] = *(const u32x4*)(ksrc + (size_t)p * 16); vv[k] = *(const u32x4*)(vsrc + (size_t)(p >> 5) * vpitch + (p & 31) * 16); }
#pragma unroll
    for (int k = 0; k < 4; ++k) { const int p = tid + NTHR * k;
        *(LAS u32x4*)(lds + AT_K_OFF + (p >> 3) * AT_KP + (p & 7) * 16) = kv[k];
        *(LAS u32x4*)(lds + AT_V_OFF + (p >> 5) * AT_VP + (p & 31) * 16) = vv[k]; }
}
template <bool FROM_LDS, bool MASK>
__device__ __forceinline__ void attn_chunk(f32x4 (&O)[4], float& m_run, float& sum, const bf16x8 q0, const bf16x8 q1,
                                           const char* kb, const char* vb, int kseg, int vseg, int vrow16, unsigned k0o, unsigned k1o, unsigned vo,
                                           LAS const unsigned char* lk, LAS const unsigned char* lv,
                                           LAS const float* rb, int band0, int g, int qc, int win0) {
    f32x4 S[4][2];
    bf16x8 Vf[4][4];
#pragma unroll
    for (int s4 = 0; s4 < 2; ++s4)
#pragma unroll
        for (int db = 0; db < 4; ++db) {
            if (!FROM_LDS) Vf[s4][db] = *(const bf16x8*)(vb + (size_t)s4 * vseg + (size_t)db * vrow16 + vo); }
#pragma unroll
    for (int s4 = 0; s4 < 4; ++s4) {
        bf16x8 a00, a01, a10, a11;
        if (FROM_LDS) { LAS const unsigned char* ks = lk + s4 * kseg;
            a00 = *(LAS const bf16x8*)(ks); a01 = *(LAS const bf16x8*)(ks + 64); a10 = *(LAS const bf16x8*)(ks + 4 * AT_KP); a11 = *(LAS const bf16x8*)(ks + 4 * AT_KP + 64); }
        else { const char* ks = kb + (size_t)s4 * kseg;
            a00 = *(const bf16x8*)(ks + k0o); a01 = *(const bf16x8*)(ks + k0o + 64); a10 = *(const bf16x8*)(ks + k1o); a11 = *(const bf16x8*)(ks + k1o + 64); }
        f32x4 c0 = (f32x4){0.f, 0.f, 0.f, 0.f}, c1 = (f32x4){0.f, 0.f, 0.f, 0.f};
        c0 = __builtin_amdgcn_mfma_f32_16x16x32_bf16(a00, q0, c0, 0, 0, 0);
        c0 = __builtin_amdgcn_mfma_f32_16x16x32_bf16(a01, q1, c0, 0, 0, 0);
        c1 = __builtin_amdgcn_mfma_f32_16x16x32_bf16(a10, q0, c1, 0, 0, 0);
        c1 = __builtin_amdgcn_mfma_f32_16x16x32_bf16(a11, q1, c1, 0, 0, 0);
        S[s4][0] = c0; S[s4][1] = c1;
        if (FROM_LDS) asm volatile("" ::: "memory");
    }
    if (!FROM_LDS) {
        asm volatile("" ::: "memory");
#pragma unroll
        for (int s4 = 2; s4 < 4; ++s4)
#pragma unroll
            for (int db = 0; db < 4; ++db) Vf[s4][db] = *(const bf16x8*)(vb + (size_t)s4 * vseg + (size_t)db * vrow16 + vo);
    }
    if (MASK) {
#pragma unroll
        for (int s4 = 0; s4 < 4; ++s4) { LAS const float* rr = rb + s4 * 31;
#pragma unroll
            for (int t = 0; t < 2; ++t)
#pragma unroll
                for (int e = 0; e < 4; ++e) { const int kc = band0 + 8 * g + 4 * t + e; const bool ok = (kc >= win0) && (kc < win0 + 16);
                    const int dc = min(max(kc - qc + 15, 0), 30);
                    S[s4][t][e] = ok ? S[s4][t][e] + rr[dc] : -INFINITY; } }
    }
    float mx = -INFINITY;
#pragma unroll
    for (int s4 = 0; s4 < 4; ++s4)
#pragma unroll
        for (int t = 0; t < 2; ++t)
#pragma unroll
            for (int e = 0; e < 4; ++e) mx = fmaxf(mx, S[s4][t][e]);
    mx = fmaxf(mx, __shfl_xor(mx, 16)); mx = fmaxf(mx, __shfl_xor(mx, 32));
    const float mnew = fmaxf(m_run, mx);
    const float scl = __builtin_amdgcn_exp2f((m_run - mnew) * 1.4426950408889634f);
    m_run = mnew;
    float ps = 0.f;
#pragma unroll
    for (int s4 = 0; s4 < 4; ++s4)
#pragma unroll
        for (int t = 0; t < 2; ++t)
#pragma unroll
            for (int e = 0; e < 4; ++e) { const float p = __builtin_amdgcn_exp2f((S[s4][t][e] - mnew) * 1.4426950408889634f); S[s4][t][e] = p; ps += p; }
    ps += __shfl_xor(ps, 16); ps += __shfl_xor(ps, 32);
    sum = sum * scl + ps;
#pragma unroll
    for (int db = 0; db < 4; ++db) O[db] = O[db] * scl;
#pragma unroll
    for (int s4 = 0; s4 < 4; ++s4) {
        u32x4 pw; pw.x = cvt_pk_bf16(S[s4][0][0], S[s4][0][1]); pw.y = cvt_pk_bf16(S[s4][0][2], S[s4][0][3]); pw.z = cvt_pk_bf16(S[s4][1][0], S[s4][1][1]); pw.w = cvt_pk_bf16(S[s4][1][2], S[s4][1][3]);
        const bf16x8 pf = __builtin_bit_cast(bf16x8, pw);
#pragma unroll
        for (int db = 0; db < 4; ++db) { if (FROM_LDS) Vf[s4][db] = *(LAS const bf16x8*)(lv + db * vrow16 + s4 * vseg);
            O[db] = __builtin_amdgcn_mfma_f32_16x16x32_bf16(Vf[s4][db], pf, O[db], 0, 0, 0); }
        if (FROM_LDS) asm volatile("" ::: "memory");
    }
    asm volatile("" ::: "memory");
}

__device__ __forceinline__ void attn_ctx_tile(const Args& a, LAS unsigned char* lds, int b, int h, int qt, int lane) {
    const char* BB = (const char*)(a.ws + WS_BIG);
    bf16_t* Y = (bf16_t*)(a.ws + WS_Y);
    const int ql = lane & 15, g = lane >> 4;
    const int qtok0 = b * LP + qt * 16;
    const char* qb = BB + (BQ_OFF + (size_t)qtok0 * D + h * HD) * 2;
    const int ci0 = 8 * (ql >> 2) + (ql & 3);
    const bf16x8 q0 = *(const bf16x8*)(qb + (unsigned)((ql * D + 8 * g) * 2)), q1 = *(const bf16x8*)(qb + (unsigned)((ql * D + 8 * g) * 2) + 64);
    LAS const unsigned char* lk = lds + AT_K_OFF + ci0 * AT_KP + 16 * g;
    LAS const unsigned char* lv = lds + AT_V_OFF + ql * AT_VP + 16 * g;
    float m_run = -INFINITY, sum = 0.f;
    f32x4 O[4];
#pragma unroll
    for (int db = 0; db < 4; ++db) O[db] = (f32x4){0.f, 0.f, 0.f, 0.f};
#pragma unroll 1
    for (int c = 0; c < 2; ++c)
        attn_chunk<true, false>(O, m_run, sum, q0, q1, nullptr, nullptr, 32 * AT_KP, 64, 16 * AT_VP, 0u, 0u, 0u, lk + c * 128 * AT_KP, lv + c * 256, (LAS const float*)lds, 0, g, 0, 0);
    const float inv = 1.0f / sum;
    bf16_t* op = Y + (size_t)(qtok0 + ql) * D + h * HD + 4 * g;
#pragma unroll
    for (int db = 0; db < 4; ++db) { u32x2 w; w.x = cvt_pk_bf16(O[db][0] * inv, O[db][1] * inv); w.y = cvt_pk_bf16(O[db][2] * inv, O[db][3] * inv); *(u32x2*)(op + db * 16) = w; }
}

__device__ __forceinline__ void attn_stage_local(const Args& a, LAS unsigned char* lds, int b, int h, int rowmin, int nrows, int cbase) {
    const int tid = opaque_tid();
    const char* BB = (const char*)(a.ws + WS_BIG);
    const char* ks = BB + (BK_OFF + (size_t)NPTOK * D + ((size_t)(b * NH + h) * LSQ + rowmin * 64 + cbase) * HD) * 2;
    const char* vs = BB + (BVS_OFF + ((size_t)(b * NH + h) * HD) * VPS + rowmin * 64 + cbase) * 2;
    const int total = nrows * 320, n5 = nrows * 5;
    { u32x4 kv[7];
#pragma unroll
      for (int k = 0; k < 7; ++k) { const int p = tid + NTHR * k;
          if (p < total) { const int kr = p / 320, rem = p - kr * 320; kv[k] = *(const u32x4*)(ks + (size_t)kr * (64 * 128) + rem * 16); } }
#pragma unroll
      for (int k = 0; k < 7; ++k) { const int p = tid + NTHR * k;
          if (p < total) { const int kr = p / 320, rem = p - kr * 320, key = rem >> 3, c16 = rem & 7; *(LAS u32x4*)(lds + AT_LK_OFF + (kr * 40 + key) * AT_KP + c16 * 16) = kv[k]; } } }
    asm volatile("" ::: "memory");
    { u32x4 vv[7];
#pragma unroll
      for (int k = 0; k < 7; ++k) { const int p = tid + NTHR * k;
          if (p < total) { const int d = p / n5, rm = p - d * n5, kr2 = rm / 5, c16 = rm - kr2 * 5; vv[k] = *(const u32x4*)(vs + (size_t)d * (VPS * 2) + kr2 * 128 + c16 * 16); } }
#pragma unroll
      for (int k = 0; k < 7; ++k) { const int p = tid + NTHR * k;
          if (p < total) { const int d = p / n5, rm = p - d * n5, kr2 = rm / 5, c16v = rm - kr2 * 5; *(LAS u32x4*)(lds + AT_LV_OFF + d * AT_LVP + kr2 * 80 + c16v * 16) = vv[k]; } } }
}

__device__ __forceinline__ void attn_latent_unit(const Args& a, LAS unsigned char* lds, int b, int h, int i4, int lane, int wave) {
    const char* BB = (const char*)(a.ws + WS_BIG);
    bf16_t* Y = (bf16_t*)(a.ws + WS_Y);
    LAS float* rpbh = (LAS float*)lds;
    const int tid = opaque_tid();
    const int rowmin = min(max(4 * i4 - 4, 0), 8), rowmax = min(max(4 * i4 - 1, 0), 8) + 7, nrows = rowmax - rowmin + 1;
    const int r = 4 * i4 + (wave >> 1), row0 = min(max(r - 4, 0), 8);
    const int ql = lane & 15, g = lane >> 4, ci0 = 8 * (ql >> 2) + (ql & 3);
    f32x4 O[2][4]; float m_run[2], sum[2];
#pragma unroll
    for (int pr = 0; pr < 2; ++pr) {
        const int j = 2 * pr + (wave & 1), cbase = 24 * pr, band0 = min(max(16 * j - 8, 0), 32), off = band0 - cbase;
        __syncthreads();
        if (pr == 0) { for (int i = tid; i < 465; i += NTHR) rpbh[i] = a.in[27][h * 465 + i]; }
        attn_stage_local(a, lds, b, h, rowmin, nrows, cbase);
        __syncthreads();
        const int qtok0 = NPTOK + b * LSQ + r * 64 + j * 16;
        const char* qb = BB + (BQ_OFF + (size_t)qtok0 * D + h * HD) * 2;
        const bf16x8 q0 = *(const bf16x8*)(qb + (unsigned)((ql * D + 8 * g) * 2)), q1 = *(const bf16x8*)(qb + (unsigned)((ql * D + 8 * g) * 2) + 64);
        m_run[pr] = -INFINITY; sum[pr] = 0.f;
#pragma unroll
        for (int db = 0; db < 4; ++db) O[pr][db] = (f32x4){0.f, 0.f, 0.f, 0.f};
        const int kl0 = (row0 - rowmin) * 40 + off;
        LAS const unsigned char* lk = lds + AT_LK_OFF + (kl0 + ci0) * AT_KP + 16 * g;
        LAS const unsigned char* lv = lds + AT_LV_OFF + ql * AT_LVP + (kl0 + 8 * g) * 2;
        const int qc = 16 * j + ql, win0 = min(max(qc - 8, 0), 48);
        LAS const float* rb = rpbh + (row0 - r + 7) * 31;
#pragma unroll 1
        for (int c = 0; c < 2; ++c)
            attn_chunk<true, true>(O[pr], m_run[pr], sum[pr], q0, q1, nullptr, nullptr, 40 * AT_KP, 80, 16 * AT_LVP, 0u, 0u, 0u,
                                   lk + c * 4 * 40 * AT_KP, lv + c * 4 * 80, rb + c * 4 * 31, band0, g, qc, win0);
    }
    __syncthreads();
    attn_stage_kv(lds, (const char*)(a.ws + WS_CK) + (size_t)(b * NH + h) * 256 * HD * 2, (const char*)(a.ws + WS_CVT) + (size_t)(b * NH + h) * HD * CVP * 2, CVP * 2);
    __syncthreads();
    {
        LAS const unsigned char* lk = lds + AT_K_OFF + ci0 * AT_KP + 16 * g;
        LAS const unsigned char* lv = lds + AT_V_OFF + ql * AT_VP + 16 * g;
#pragma unroll
        for (int pr = 0; pr < 2; ++pr) {
            const int j = 2 * pr + (wave & 1);
            const int qtok0 = NPTOK + b * LSQ + r * 64 + j * 16;
            const char* qb = BB + (BQ_OFF + (size_t)qtok0 * D + h * HD) * 2;
            const bf16x8 q0 = *(const bf16x8*)(qb + (unsigned)((ql * D + 8 * g) * 2)), q1 = *(const bf16x8*)(qb + (unsigned)((ql * D + 8 * g) * 2) + 64);
#pragma unroll 1
            for (int c = 0; c < 2; ++c)
                attn_chunk<true, false>(O[pr], m_run[pr], sum[pr], q0, q1, nullptr, nullptr, 32 * AT_KP, 64, 16 * AT_VP, 0u, 0u, 0u, lk + c * 128 * AT_KP, lv + c * 256, rpbh, 0, g, 0, 0);
            const float inv = 1.0f / sum[pr];
            bf16_t* op = Y + (size_t)(qtok0 + ql) * D + h * HD + 4 * g;
#pragma unroll
            for (int db = 0; db < 4; ++db) { u32x2 w; w.x = cvt_pk_bf16(O[pr][db][0] * inv, O[pr][db][1] * inv); w.y = cvt_pk_bf16(O[pr][db][2] * inv, O[pr][db][3] * inv); *(u32x2*)(op + db * 16) = w; }
        }
    }
}

__device__ __forceinline__ void attn_phase(const Args& a, LAS unsigned char* lds) {
    const int tid = opaque_tid(), lane = tid & 63, wave = __builtin_amdgcn_readfirstlane(tid >> 6), bx = blockIdx.x, G = gridDim.x;
    const int vcu = (G % 8 == 0) ? (bx % 8) * (G / 8) + bx / 8 : bx;
    const char* BB = (const char*)(a.ws + WS_BIG);
    for (int u = vcu; u < 256; u += G) { const int bh = u >> 2; attn_latent_unit(a, lds, bh >> 4, bh & 15, u & 3, lane, wave); }
    for (int u = vcu; u < 256; u += G) {
        const int b = u >> 4, h = u & 15;
        __syncthreads();
        attn_stage_kv(lds, BB + (BK_OFF + (size_t)u * LP * HD) * 2, BB + (BV_OFF + (size_t)u * HD * VPP) * 2, VPP * 2);
        __syncthreads();
#pragma unroll 1
        for (int tt = 0; tt < 2; ++tt) attn_ctx_tile(a, lds, b, h, 2 * wave + tt, lane);
    }
    __syncthreads();
}

__device__ __forceinline__ void cache_convert(const Args& a, int slot, int nslots) {
    const int tid = opaque_tid();
    const int gt = slot * NTHR + tid, NGT = nslots * NTHR;
    for (int i = gt; i < 131072; i += NGT) {
        const f32x4 x0 = *(const f32x4*)(a.in[2] + (size_t)i * 8), x1 = *(const f32x4*)(a.in[2] + (size_t)i * 8 + 4);
        u32x4 o; o.x = cvt_pk_bf16(x0[0], x0[1]); o.y = cvt_pk_bf16(x0[2], x0[3]); o.z = cvt_pk_bf16(x1[0], x1[1]); o.w = cvt_pk_bf16(x1[2], x1[3]);
        *(u32x4*)((bf16_t*)(a.ws + WS_CK) + (size_t)i * 8) = o;
        const int d = i & 63, sg = (i >> 6) & 31, bh = i >> 11;
        const float* src = a.in[3] + ((size_t)bh * 256 + 8 * sg) * 64 + d;
        u32x4 p; p.x = cvt_pk_bf16(src[0], src[64]); p.y = cvt_pk_bf16(src[128], src[192]); p.z = cvt_pk_bf16(src[256], src[320]); p.w = cvt_pk_bf16(src[384], src[448]);
        *(u32x4*)((bf16_t*)(a.ws + WS_CVT) + ((size_t)bh * 64 + d) * CVP + 8 * sg) = p;
    }
}

#ifndef PHASES
#define PHASES 0xFFFFFFFFu
#endif
#define PH(k) ((PHASES >> (k)) & 1u)
#ifndef REP
#define REP 0x0u
#endif
#ifndef HYREP
#define HYREP 0x0u
#endif
#ifndef XSYNC
#define XSYNC 0
#endif
#define RP(k) for (int rep_ = 0; rep_ <= (int)((REP >> (k)) & 1u); ++rep_)
__global__ void __launch_bounds__(NTHR, 2) fwd_megakernel(Args a) {
    extern __shared__ __attribute__((aligned(16))) unsigned char lds_raw[];
    LAS unsigned char* lds = (LAS unsigned char*)lds_raw;
    cg::grid_group grid = cg::this_grid();
    if (a.ws == nullptr) grid.sync();
    if (opaque_tid() < 64) ((volatile LAS unsigned*)(lds + LDS_CTL))[opaque_tid()] = 0u;
    __syncthreads();
    const XcdBarrier xbar = xcd_barrier_post((unsigned*)(a.ws + WS_BAR), (volatile LAS unsigned*)(lds + LDS_CTL));
#define GSYNC() xcd_barrier(xbar)
#define LSYNC() do { if (xl_ok) xcd_local_barrier(xbar); else xcd_barrier(xbar); } while (0)
#define IDLE_DEFER(ntot, r0, r1, cid) do { const int rounds_ = ((ntot) + G - 1) / G, nidle_ = rounds_ * G - (ntot); \
    if (nidle_ > 0) { if (cid >= G - nidle_) deferred_transposes(a, lds, r0, r1, cid - (G - nidle_), nidle_); } else deferred_transposes(a, lds, r0, r1, cid, G); } while (0)
    const int G = gridDim.x, bx = blockIdx.x;
    unsigned char* ws = a.ws;
    const float* ada = (const float*)(ws + WS_ADA);
    bf16_t* H = (bf16_t*)(ws + WS_H); bf16_t* Yb = (bf16_t*)(ws + WS_Y);
    bf16_t* X = (bf16_t*)(ws + WS_X); bf16_t* P0 = (bf16_t*)(ws + WS_P0); bf16_t* P1 = (bf16_t*)(ws + WS_P1);
    bf16_t* BIG = (bf16_t*)(ws + WS_BIG);

    RP(0) { if (PH(0)) { p0_prep(a, lds); }
      GSYNC(); }
    const unsigned xl_ok = (unsigned)__builtin_amdgcn_readfirstlane((int)xbar.st[2]);
    const int vb = xl_ok ? __builtin_amdgcn_readfirstlane((int)(xbar.st[3] * 8u + xbar.x)) : bx;
    const int vbln = xl_ok ? vb : -1;

    RP(2) { if (PH(2)) { { pg8::Gemm g{(const bf16_t*)(ws + WS_WHYIN), H, 1024, 1024}; pg8::Order S; S.init(3072, NTOK, 1, G, bx);
      pg8::EpiBf16T E{BIG, NTOK}; pg8::gemm_phase(lds, g, S, E); }
      { const int nidle_c = 2 * G - 384; if (nidle_c > 0 && nidle_c <= G) { if (bx >= G - nidle_c) cache_convert(a, bx - (G - nidle_c), nidle_c); } else cache_convert(a, bx, G); }
      IDLE_DEFER(384, TR_S1_BEG, TR_S1_END, bx); }
      GSYNC(); }
    RP(3) { if (PH(3)) { { for (int it = bx; it < 256; it += G) { hyena_item<1024, 2>(a, lds, 8 * (it >> 1), NPTOK + 2048 * (it & 1)); hyena_item<256, 8>(a, lds, 8 * (it >> 1), 2048 * (it & 1)); } } }
      GSYNC(); }
    RP(4) { if (PH(4)) { { pg8::Gemm g{Yb, (const bf16_t*)(ws + WS_WHYOUT), 512, 1024}; pg8::Order S; S.init(NTOK, 1024, 2, G, vb);
      pg8::EpiRes<true> E{a.in[0], a.in[1], ada + 2048, P0, P1}; pg8::gemm_phase(lds, g, S, E); } }
      LSYNC(); }
    RP(5) { if (PH(5)) { ln_phase<false>(a, a.in[8], a.in[9], nullptr, ada + 3072, vbln, a.in[0], a.in[1]); }
      LSYNC(); }
    RP(6) { if (PH(6)) { { pg8::Gemm g{H, (const bf16_t*)(ws + WS_WFFIN), 1024, 1024}; pg8::Order S; S.init(NTOK, 5632, 1, G, vb);
      pg8::EpiSwiglu E{BIG}; pg8::gemm_phase(lds, g, S, E); }
      IDLE_DEFER(704, TR_S2_BEG, TR_S2_END, vb); }
      LSYNC(); }
    RP(7) { if (PH(7)) { { pg8::Gemm g{BIG, (const bf16_t*)(ws + WS_WFFOUT), 1408, DFF}; pg8::Order S; S.init(NTOK, 1024, 2, G, vb);
      pg8::EpiRes<false> E{X, X + (size_t)NPTOK * D, ada + 5120, P0, P1}; pg8::gemm_phase(lds, g, S, E); } }
      LSYNC(); }
    RP(8) { if (PH(8)) { ln_phase<false>(a, a.in[10], a.in[11], nullptr, ada + 5 * 6144, vbln);   }
      GSYNC(); }

    for (int xs_ = 0; xs_ < XSYNC; ++xs_) GSYNC();
    RP(9) { if (PH(9)) { { pg8::Gemm g{H, (const bf16_t*)(ws + WS_WQKV), 1024, 1024}; pg8::Order S; S.init(NTOK, 3072, 1, G, bx);
      pg8::EpiQKV E{BIG, a.out + (size_t)NTOK * D, a.out + (size_t)NTOK * D + (size_t)NPTOK * D}; pg8::gemm_phase(lds, g, S, E); }
      IDLE_DEFER(384, TR_S3_BEG, TR_S3_END, bx); }
      GSYNC(); }
    RP(10) { if (PH(10)) { attn_phase(a, lds); }
      GSYNC(); }
    RP(11) { if (PH(11)) { { pg8::Gemm g{Yb, (const bf16_t*)(ws + WS_WNAOUT), 512, 1024}; pg8::Order S; S.init(NTOK, 1024, 2, G, vb);
      pg8::EpiRes<false> E{X, X + (size_t)NPTOK * D, ada + 5 * 6144 + 2048, P0, P1}; pg8::gemm_phase(lds, g, S, E); } }
      LSYNC(); }
    RP(12) { if (PH(12)) { ln_phase<false>(a, a.in[8] + D, a.in[9] + D, nullptr, ada + 5 * 6144 + 3072, vbln); }
      LSYNC(); }
    RP(13) { if (PH(13)) { { pg8::Gemm g{H, (const bf16_t*)(ws + WS_WFFIN) + (size_t)5632 * 1024, 1024, 1024}; pg8::Order S; S.init(NTOK, 5632, 1, G, vb);
      pg8::EpiSwiglu E{BIG}; pg8::gemm_phase(lds, g, S, E); } }
      LSYNC(); }
    RP(14) { if (PH(14)) { { pg8::Gemm g{BIG, (const bf16_t*)(ws + WS_WFFOUT) + (size_t)1024 * DFF, 1408, DFF}; pg8::Order S; S.init(NTOK, 1024, 2, G, vb);
      pg8::EpiRes<false> E{X, X + (size_t)NPTOK * D, ada + 5 * 6144 + 5120, P0, P1}; pg8::gemm_phase(lds, g, S, E); } }
      LSYNC(); }
    RP(15) { if (PH(15)) { ln_phase<true>(a, a.in[10] + D, a.in[11] + D, a.out, ada, vbln); } }
}

extern "C" void kernel_launch(void* const* d_in, const int* in_sizes, int n_in, void* d_out, int out_size, void* d_ws, size_t ws_size, hipStream_t stream) {
    static int grid = 0;
    if (grid == 0) {
        if (n_in != 29 || ws_size < WS_END) { fprintf(stderr, "kernel_launch: unexpected n_in %d or ws_size %zu (need %zu)\n", n_in, ws_size, (size_t)WS_END); grid = -1; return; }
        int dev = 0, cus = 0, per_cu = 0;
        hipGetDevice(&dev);
        hipDeviceGetAttribute(&cus, hipDeviceAttributeMultiprocessorCount, dev);
        if (hipFuncSetAttribute((const void*)fwd_megakernel, hipFuncAttributeMaxDynamicSharedMemorySize, LDS_BYTES) != hipSuccess) { fprintf(stderr, "kernel_launch: hipFuncSetAttribute failed\n"); grid = -1; return; }
        if (hipOccupancyMaxActiveBlocksPerMultiprocessor(&per_cu, (const void*)fwd_megakernel, NTHR, LDS_BYTES) != hipSuccess || per_cu < 1) { fprintf(stderr, "kernel_launch: occupancy query says %d\n", per_cu); per_cu = 1; }
        (void)hipGetLastError();
        grid = cus;
        if (grid > 256) grid = 256;
    }
    if (grid < 0) return;
    if (hipMemsetAsync((char*)d_ws + WS_BAR, 0, XB_ALL_WORDS * 4, stream) != hipSuccess) { fprintf(stderr, "kernel_launch: memset failed\n"); return; }
    Args a{};
    for (int i = 0; i < 29; ++i) a.in[i] = (const float*)d_in[i];
    a.out = (float*)d_out; a.ws = (unsigned char*)d_ws;
    void* args[] = {&a};
    hipError_t e = hipLaunchCooperativeKernel((const void*)fwd_megakernel, dim3(grid), dim3(NTHR), args, LDS_BYTES, stream);
    if (e != hipSuccess) fprintf(stderr, "cooperative launch failed: %s (grid %d)\n", hipGetErrorString(e), grid);
}
```

```cpp
#include <hip/hip_runtime.h>
#include <hip/hip_cooperative_groups.h>
#include <cstdio>
#include <cstdint>
namespace cg = cooperative_groups;

#define LAS __attribute__((address_space(3)))
typedef unsigned short bf16_t;
typedef short bf16x8 __attribute__((ext_vector_type(8)));
typedef float f32x4 __attribute__((ext_vector_type(4)));
typedef float f32x16 __attribute__((ext_vector_type(16)));
typedef unsigned u32x4 __attribute__((ext_vector_type(4)));
typedef unsigned u32x2 __attribute__((ext_vector_type(2)));

#ifndef HYREP
#define HYREP 0x0u
#endif
#ifndef P0REP
#define P0REP 0x0u
#endif
constexpr int D = 1024, NTOK = 8192, NPTOK = 4096, LP = 256, LSQ = 1024, DFF = 2816, NH = 16, HD = 64;
constexpr float ALPHA_C = 1.4142135623730951f;
constexpr float LN_EPS_C = 1e-5f;
constexpr int NWAVES = 8, NTHR = 512;
constexpr int LDS_BYTES = 147456;
constexpr int HY_WSTR = 17408;
constexpr int LDS_CTL = 8 * HY_WSTR;
constexpr int HY_ZERO = LDS_CTL + 64;

constexpr size_t MB = 1024 * 1024;
constexpr size_t WS_ADA    = 0;
constexpr size_t WS_BAR    = 245760;
constexpr size_t WS_WHYIN  = 256 * 1024;
constexpr size_t WS_WHYOUT = WS_WHYIN + 6 * MB;
constexpr size_t WS_WQKV   = WS_WHYOUT + 2 * MB;
constexpr size_t WS_WNAOUT = WS_WQKV + 6 * MB;
constexpr size_t WS_WFFIN  = WS_WNAOUT + 2 * MB;
constexpr size_t WS_WFFOUT = WS_WFFIN + 22 * MB;
constexpr size_t WS_RF256  = WS_WFFOUT + 11 * MB;
constexpr size_t WS_RF1024 = WS_RF256 + 1 * MB;
constexpr size_t WS_CK     = WS_RF1024 + 4 * MB;
constexpr size_t WS_CVT    = WS_CK + 2 * MB;
constexpr size_t WS_H      = WS_CVT + 4 * MB;
constexpr size_t WS_Y      = WS_H + 16 * MB;
constexpr size_t WS_X      = WS_Y + 16 * MB;
constexpr size_t WS_P0     = WS_X + 32 * MB;
constexpr size_t WS_P1     = WS_P0 + 32 * MB;
constexpr size_t WS_BIG    = WS_P1 + 32 * MB;
constexpr size_t WS_END    = WS_BIG + 64 * MB;
constexpr int VPP = 384, VPS = 1152, CVP = 384;
constexpr size_t BQ_OFF = 0, BK_OFF = (size_t)NTOK * D, BV_OFF = 2 * (size_t)NTOK * D, BVS_OFF = BV_OFF + (size_t)16 * NH * HD * VPP;

__device__ __forceinline__ int opaque_tid() { int t = threadIdx.x; asm volatile("" : "+v"(t)); return t; }
typedef float f32x2 __attribute__((ext_vector_type(2)));
typedef __bf16 bf16x2v __attribute__((ext_vector_type(2)));
__device__ __forceinline__ unsigned cvt_pk_bf16(float lo, float hi) { const f32x2 v = {lo, hi}; const bf16x2v b = __builtin_convertvector(v, bf16x2v); return __builtin_bit_cast(unsigned, b); }
__device__ __forceinline__ bf16_t f2bf(float x) { return (bf16_t)(cvt_pk_bf16(x, 0.f) & 0xffffu); }
__device__ __forceinline__ float bf2f(bf16_t b) { return __uint_as_float(((unsigned)b) << 16); }
__device__ __forceinline__ float bflo(unsigned w) { return __uint_as_float(w << 16); }
__device__ __forceinline__ float bfhi(unsigned w) { return __uint_as_float(w & 0xffff0000u); }
__device__ __forceinline__ float silu_f(float x) { return x * __builtin_amdgcn_rcpf(1.0f + __builtin_amdgcn_exp2f(-1.4426950408889634f * x)); }
__device__ __forceinline__ float wave_sum(float v) {
#pragma unroll
    for (int o = 1; o < 64; o <<= 1) v += __shfl_xor(v, o);
    return v;
}

namespace pg8 {
constexpr int BM = 256, BK = 64, HALF = 128, HTB = HALF * BK * 2, STAGE_BYTES = 8 * HTB, NXCD = 8, WGM = 4;
__device__ __forceinline__ int lds_byte(int r, int c) { const int st = (r >> 4) * 2 + (c >> 5), rr = r & 15, cc = c & 31, ob = rr * 64 + cc * 2; return st * 1024 + (ob ^ (((ob >> 9) & 1) << 5)); }
__device__ __forceinline__ void stage_rc(int b, int& R, int& C) { const int st = b / 1024, sb = b % 1024, swz = sb ^ (((sb >> 9) & 1) << 5); R = (st >> 1) * 16 + swz / 64; C = (st & 1) * 32 + (swz % 64) / 2; }
__device__ __forceinline__ int perm32(int rho) { const int n = rho >> 4, i = rho & 15; return 8 * (i >> 2) + 4 * n + (i & 3); }

struct Unit { int pm, pn, kh; };
struct Gemm { const bf16_t* A; const bf16_t* Bt; int K; int ld; };

struct Order {
    int nM, nN, nmn, ntot, G, c;
    __device__ void init(int M, int N, int ks, int G_, int c_) { nM = M / BM; nN = N / BM; nmn = nM * nN; ntot = nmn * ks; G = G_; c = c_; }
    __device__ bool next(int i, Unit& u) const {
        const int L = i * G + c; if (L >= ntot) return false;
        u.kh = L / nmn; int wgid = L - u.kh * nmn;
        { const int q = nmn / NXCD, r = nmn % NXCD, xcd = wgid % NXCD, off = wgid / NXCD; wgid = (xcd < r ? xcd * (q + 1) : r * (q + 1) + (xcd - r) * q) + off; }
        const int nig = WGM * nN, gid = wgid / nig, fm = gid * WGM, gsz = (nM - fm) < WGM ? (nM - fm) : WGM;
        u.pm = fm + ((wgid % nig) % gsz); u.pn = (wgid % nig) / gsz; return true;
    }
};

template <class Epi>
__device__ __forceinline__ void gemm_phase(LAS unsigned char* lds, const Gemm g, const Order& S, const Epi& E) {
    const int tid = opaque_tid(), wid = __builtin_amdgcn_readfirstlane(tid >> 6), lane = tid & 63, wr = wid >> 2, wc = wid & 3, fr = lane & 15, fq = lane >> 4;
    const int K = g.ld, nt = g.K / BK;
    unsigned voffA[2], voffB[2];
#pragma unroll
    for (int i = 0; i < 2; ++i) { int R, C; stage_rc(tid * 16 + i * 8192, R, C); const int Rb = Epi::PERM ? ((R & ~31) + perm32(R & 31)) : R;
        voffA[i] = (unsigned)(R * K + C) * 2u; voffB[i] = (unsigned)(Rb * K + C) * 2u; }
    const size_t kstep = (size_t)(BK * 2);
    const size_t hstep = (size_t)HALF * K * 2;
    const size_t tstep = 2 * hstep;
    const size_t khstep = (size_t)g.K * 2;
    const unsigned ldsw = (unsigned)wid * 1024u;
    const int aoff = lds_byte(wr * 64 + fr, fq * 8), boff = lds_byte(wc * 32 + fr, fq * 8);
#define PG8_SA(b, h) (((b) * 2 + (h)) * HTB)
#define PG8_SB(b, h) ((4 + (b) * 2 + (h)) * HTB)
#define PG8_STAGE(bufoff, gbase, voff) do { _Pragma("unroll") for (int _i = 0; _i < 2; ++_i) \
        __builtin_amdgcn_global_load_lds((const unsigned*)((const char*)(gbase) + (voff)[_i]), (LAS unsigned*)(lds + (bufoff) + ldsw + _i * 8192), 16, 0, 0); } while (0)
#define PG8_LDA(dst, b, h) do { _Pragma("unroll") for (int m = 0; m < 4; ++m) _Pragma("unroll") for (int k = 0; k < 2; ++k) dst[m][k] = *(const LAS bf16x8*)(lds + PG8_SA(b, h) + aoff + m * 2048 + k * 1024); } while (0)
#define PG8_LDB(dst, b, h) do { _Pragma("unroll") for (int n = 0; n < 2; ++n) _Pragma("unroll") for (int k = 0; k < 2; ++k) dst[n][k] = *(const LAS bf16x8*)(lds + PG8_SB(b, h) + boff + n * 2048 + k * 1024); } while (0)
#define PG8_MMA(ai, bj, At, Bt) do { __builtin_amdgcn_s_setprio(1); _Pragma("unroll") for (int m = 0; m < 4; ++m) _Pragma("unroll") for (int n = 0; n < 2; ++n) _Pragma("unroll") for (int k = 0; k < 2; ++k) \
        acc[ai][bj][m][n] = __builtin_amdgcn_mfma_f32_16x16x32_bf16(Bt[n][k], At[m][k], acc[ai][bj][m][n], 0, 0, 0); __builtin_amdgcn_s_setprio(0); } while (0)
#define PG8_WAIT_V(n) asm volatile("s_waitcnt vmcnt(" #n ")" ::: "memory")
#define PG8_WAIT_L(n) asm volatile("s_waitcnt lgkmcnt(" #n ")" ::: "memory")
#define PG8_BAR __builtin_amdgcn_s_barrier()
#define PG8_SCHED __builtin_amdgcn_sched_barrier(0)
    Unit cur, nxt; int ui = 0;
    if (!S.next(0, cur)) return;
    f32x4 acc[2][2][4][2];
#pragma unroll
    for (int a = 0; a < 2; ++a)
#pragma unroll
        for (int b = 0; b < 2; ++b)
#pragma unroll
            for (int m = 0; m < 4; ++m)
#pragma unroll
                for (int n = 0; n < 2; ++n) acc[a][b][m][n] = (f32x4){0.f, 0.f, 0.f, 0.f};
    bf16x8 At[4][2], B0[2][2], B1[2][2];
    const char* cA = (const char*)g.A + (size_t)cur.pm * tstep + (size_t)cur.kh * khstep; const char* cB = (const char*)g.Bt + (size_t)cur.pn * tstep + (size_t)cur.kh * khstep;
    PG8_STAGE(PG8_SB(0, 0), cB, voffB); PG8_STAGE(PG8_SB(0, 1), cB + hstep, voffB); PG8_STAGE(PG8_SA(0, 0), cA, voffA); PG8_STAGE(PG8_SA(0, 1), cA + hstep, voffA);
    if (wr == 1) PG8_BAR;
    PG8_WAIT_V(2); PG8_BAR;
    PG8_STAGE(PG8_SB(1, 0), cB + kstep, voffB); PG8_STAGE(PG8_SA(1, 0), cA + kstep, voffA); PG8_STAGE(PG8_SB(1, 1), cB + hstep + kstep, voffB);
    PG8_WAIT_V(6); PG8_BAR;
    for (;;) {
        const bool has_next = S.next(ui + 1, nxt);
        const char* nA = has_next ? (const char*)g.A + (size_t)nxt.pm * tstep + (size_t)nxt.kh * khstep : cA; const char* nB = has_next ? (const char*)g.Bt + (size_t)nxt.pn * tstep + (size_t)nxt.kh * khstep : cB;
        for (int t = 0; t < nt; t += 2) {
            const bool last = (t == nt - 2);
            const char* a1 = cA + (size_t)(t + 1) * kstep;
            const char* a2 = last ? nA : cA + (size_t)(t + 2) * kstep; const char* b2 = last ? nB : cB + (size_t)(t + 2) * kstep;
            const char* a3 = a2 + kstep; const char* b3 = b2 + kstep;
            PG8_LDB(B0, 0, 0); PG8_LDB(B1, 0, 1); PG8_SCHED; PG8_LDA(At, 0, 0); PG8_STAGE(PG8_SA(1, 1), a1 + hstep, voffA);
            PG8_WAIT_V(8); PG8_WAIT_L(0); PG8_BAR; PG8_MMA(0, 0, At, B0); PG8_MMA(0, 1, At, B1); PG8_BAR; PG8_SCHED;
            PG8_LDA(At, 0, 1); PG8_STAGE(PG8_SB(0, 0), b2, voffB); PG8_STAGE(PG8_SB(0, 1), b2 + hstep, voffB); PG8_STAGE(PG8_SA(0, 0), a2, voffA);
            PG8_WAIT_V(8); PG8_WAIT_L(0); PG8_BAR; PG8_MMA(1, 0, At, B0); PG8_MMA(1, 1, At, B1); PG8_BAR; PG8_SCHED;
            PG8_LDB(B0, 1, 0); PG8_LDB(B1, 1, 1); PG8_SCHED; PG8_LDA(At, 1, 0); PG8_STAGE(PG8_SA(0, 1), a2 + hstep, voffA);
            PG8_WAIT_V(8); PG8_WAIT_L(0); PG8_BAR; PG8_MMA(0, 0, At, B0); PG8_MMA(0, 1, At, B1); PG8_BAR; PG8_SCHED;
            PG8_LDA(At, 1, 1); PG8_STAGE(PG8_SB(1, 0), b3, voffB); PG8_STAGE(PG8_SB(1, 1), b3 + hstep, voffB); PG8_STAGE(PG8_SA(1, 0), a3, voffA);
            PG8_WAIT_V(8); PG8_WAIT_L(0); PG8_BAR; PG8_MMA(1, 0, At, B0); PG8_MMA(1, 1, At, B1); PG8_BAR; PG8_SCHED;
        }
        if (wr == 0) PG8_BAR;
        E(acc, cur, wr, wc, fr, fq);
        if (!has_next) break;
#pragma unroll
        for (int a = 0; a < 2; ++a)
#pragma unroll
            for (int b = 0; b < 2; ++b)
#pragma unroll
                for (int m = 0; m < 4; ++m)
#pragma unroll
                    for (int n = 0; n < 2; ++n) acc[a][b][m][n] = (f32x4){0.f, 0.f, 0.f, 0.f};
        cur = nxt; cA = nA; cB = nB; ++ui;
        if (wr == 1) PG8_BAR;
    }
    PG8_WAIT_V(0);
    PG8_BAR;
#undef PG8_SA
#undef PG8_SB
#undef PG8_STAGE
#undef PG8_LDA
#undef PG8_LDB
#undef PG8_MMA
#undef PG8_WAIT_V
#undef PG8_WAIT_L
#undef PG8_BAR
#undef PG8_SCHED
}

struct EpiBf16T {
    static constexpr bool PERM = true;
    bf16_t* O; int ldc;
    __device__ __forceinline__ void operator()(const f32x4 (&acc)[2][2][4][2], const Unit& u, int wr, int wc, int fr, int fq) const {
        const int row0 = u.pm * BM + wr * 64 + fr, col0 = u.pn * BM + wc * 32 + 8 * fq;
#pragma unroll
        for (int ai = 0; ai < 2; ++ai)
#pragma unroll
            for (int m = 0; m < 4; ++m) { bf16_t* rowp = O + (size_t)(row0 + ai * HALF + m * 16) * ldc + col0;
#pragma unroll
                for (int bj = 0; bj < 2; ++bj) { const f32x4 v0 = acc[ai][bj][m][0], v1 = acc[ai][bj][m][1];
                    u32x4 w; w.x = cvt_pk_bf16(v0[0], v0[1]); w.y = cvt_pk_bf16(v0[2], v0[3]); w.z = cvt_pk_bf16(v1[0], v1[1]); w.w = cvt_pk_bf16(v1[2], v1[3]);
                    *(u32x4*)(rowp + bj * HALF) = w; } }
    }
};
template <bool BASE_F32>
struct EpiRes {
    static constexpr bool PERM = true;
    const void* bp; const void* bs;
    const float* gate;
    bf16_t* P0; bf16_t* P1;
    __device__ __forceinline__ void operator()(const f32x4 (&acc)[2][2][4][2], const Unit& u, int wr, int wc, int fr, int fq) const {
        const int row0 = u.pm * BM + wr * 64 + fr, col0 = u.pn * BM + wc * 32 + 8 * fq;
        const int v = (u.pm < 16) ? 0 : 1 + ((u.pm - 16) >> 2);
        f32x4 gv[2][2];
#pragma unroll
        for (int bj = 0; bj < 2; ++bj)
#pragma unroll
            for (int n = 0; n < 2; ++n) gv[bj][n] = *(const f32x4*)(gate + v * 6144 + col0 + bj * HALF + 4 * n);
        bf16_t* P = u.kh ? P1 : P0;
#pragma unroll
        for (int ai = 0; ai < 2; ++ai)
#pragma unroll
            for (int m = 0; m < 4; ++m) { bf16_t* rowp = P + (size_t)(row0 + ai * HALF + m * 16) * D + col0;
#pragma unroll
                for (int bj = 0; bj < 2; ++bj) { const f32x4 y0 = gv[bj][0] * acc[ai][bj][m][0], y1 = gv[bj][1] * acc[ai][bj][m][1];
                    u32x4 w; w.x = cvt_pk_bf16(y0[0], y0[1]); w.y = cvt_pk_bf16(y0[2], y0[3]); w.z = cvt_pk_bf16(y1[0], y1[1]); w.w = cvt_pk_bf16(y1[2], y1[3]);
                    *(u32x4*)(rowp + bj * HALF) = w; } }
    }
};
struct EpiSwiglu {
    static constexpr bool PERM = true;
    bf16_t* O;
    __device__ __forceinline__ void operator()(const f32x4 (&acc)[2][2][4][2], const Unit& u, int wr, int wc, int fr, int fq) const {
        const int row0 = u.pm * BM + wr * 64 + fr;
#pragma unroll
        for (int ai = 0; ai < 2; ++ai)
#pragma unroll
            for (int m = 0; m < 4; ++m) { bf16_t* rowp = O + (size_t)(row0 + ai * HALF + m * 16) * DFF + u.pn * 128 + wc * 32 + 8 * fq;
                const f32x4 a0 = acc[ai][0][m][0], a1 = acc[ai][0][m][1], b0 = acc[ai][1][m][0], b1 = acc[ai][1][m][1];
                u32x4 w; w.x = cvt_pk_bf16(silu_f(a0[0]) * b0[0], silu_f(a0[1]) * b0[1]); w.y = cvt_pk_bf16(silu_f(a0[2]) * b0[2], silu_f(a0[3]) * b0[3]);
                w.z = cvt_pk_bf16(silu_f(a1[0]) * b1[0], silu_f(a1[1]) * b1[1]); w.w = cvt_pk_bf16(silu_f(a1[2]) * b1[2], silu_f(a1[3]) * b1[3]);
                *(u32x4*)rowp = w; }
    }
};
struct EpiQKV {
    static constexpr bool PERM = true;
    bf16_t* B; float* newk; float* newv;
    __device__ __forceinline__ void operator()(const f32x4 (&acc)[2][2][4][2], const Unit& u, int wr, int wc, int fr, int fq) const {
        const int row0 = u.pm * BM + wr * 64 + fr, col0 = u.pn * BM + wc * 32 + 8 * fq;
        const bool prompt = u.pm < 16;
        if (u.pn < 4) {
#pragma unroll
            for (int ai = 0; ai < 2; ++ai)
#pragma unroll
                for (int m = 0; m < 4; ++m) { const int row = row0 + ai * HALF + m * 16; bf16_t* rowp = B + BQ_OFF + (size_t)row * D + col0;
#pragma unroll
                    for (int bj = 0; bj < 2; ++bj) { const f32x4 x0 = acc[ai][bj][m][0] * 0.125f, x1 = acc[ai][bj][m][1] * 0.125f;
                        u32x4 w; w.x = cvt_pk_bf16(x0[0], x0[1]); w.y = cvt_pk_bf16(x0[2], x0[3]); w.z = cvt_pk_bf16(x1[0], x1[1]); w.w = cvt_pk_bf16(x1[2], x1[3]);
                        *(u32x4*)(rowp + bj * HALF) = w; } }
        } else if (u.pn < 8) {
#pragma unroll
            for (int ai = 0; ai < 2; ++ai)
#pragma unroll
                for (int m = 0; m < 4; ++m) { const int row = row0 + ai * HALF + m * 16;
                    int b, s, L; size_t kb;
                    if (prompt) { b = row >> 8; s = row & 255; L = LP; kb = BK_OFF; } else { b = (row - NPTOK) >> 10; s = (row - NPTOK) & 1023; L = LSQ; kb = BK_OFF + (size_t)NPTOK * D; }
#pragma unroll
                    for (int bj = 0; bj < 2; ++bj) { const int c = col0 + bj * HALF - 1024, hh = c >> 6, dd = c & 63; const f32x4 x0 = acc[ai][bj][m][0], x1 = acc[ai][bj][m][1];
                        u32x4 w; w.x = cvt_pk_bf16(x0[0], x0[1]); w.y = cvt_pk_bf16(x0[2], x0[3]); w.z = cvt_pk_bf16(x1[0], x1[1]); w.w = cvt_pk_bf16(x1[2], x1[3]);
                        *(u32x4*)(B + kb + ((size_t)((b * NH + hh) * L + s)) * HD + dd) = w;
                        if (prompt) { float* nk = newk + ((size_t)((b * NH + hh) * LP + s)) * HD + dd; *(f32x4*)nk = x0; *(f32x4*)(nk + 4) = x1; } } }
        } else {
            const bool odd = (fr & 1) != 0;
#pragma unroll
            for (int ai = 0; ai < 2; ++ai)
#pragma unroll
                for (int m = 0; m < 4; ++m) { const int row = row0 + ai * HALF + m * 16;
                    int b, s, P; size_t vb;
                    if (prompt) { b = row >> 8; s = row & 255; P = VPP; vb = BV_OFF; } else { b = (row - NPTOK) >> 10; s = (row - NPTOK) & 1023; P = VPS; vb = BVS_OFF; }
#pragma unroll
                    for (int bj = 0; bj < 2; ++bj)
#pragma unroll
                        for (int n = 0; n < 2; ++n) { const int c = col0 + bj * HALF + 4 * n - 2048, hh = c >> 6, dd = c & 63; const f32x4 x = acc[ai][bj][m][n];
                            f32x4 y;
#pragma unroll
                            for (int e = 0; e < 4; ++e) y[e] = __shfl_xor(x[e], 1);
                            const unsigned w0 = odd ? cvt_pk_bf16(y[1], x[1]) : cvt_pk_bf16(x[0], y[0]);
                            const unsigned w1 = odd ? cvt_pk_bf16(y[3], x[3]) : cvt_pk_bf16(x[2], y[2]);
                            bf16_t* vq = B + vb + ((size_t)((b * NH + hh) * HD + dd + (odd ? 1 : 0))) * P + (s & ~1);
                            *(unsigned*)vq = w0; *(unsigned*)(vq + 2 * P) = w1;
                            if (prompt) *(f32x4*)(newv + ((size_t)((b * NH + hh) * LP + s)) * HD + dd) = x; } }
        }
    }
};
}


#define XB_TMO      128
#define XB_XCNT(j)  (256  + 64 * (j))
#define XB_XSUB(j)  (1280 + 64 * (j))
#define XB_XGEN(j)  (2304 + 64 * (j))
#define XB_TOP      3328
#define XB_TOPGEN   3392
#define XCD_BAR_WORDS 3456
#define XB_LSUB(j)  (3456 + 16 * (j))
#define XB_LGEN(j)  (3712 + 16 * (j))
#define XB_ALL_WORDS 4096
#define XB_SPIN_CAP (1u << 18)
__device__ __forceinline__ unsigned xb_ld(unsigned* p)              { return __hip_atomic_load(p, __ATOMIC_RELAXED, __HIP_MEMORY_SCOPE_AGENT); }
__device__ __forceinline__ unsigned xb_add(unsigned* p, unsigned v) { return __hip_atomic_fetch_add(p, v, __ATOMIC_RELAXED, __HIP_MEMORY_SCOPE_AGENT); }
__device__ __forceinline__ unsigned xb_xcc_id() { return (unsigned)__builtin_amdgcn_s_getreg((3 << 11) | 20) & 0xFu; }
#define XB_SPIN(cond, bar) do { unsigned _sp = 0; while (cond) { __builtin_amdgcn_s_sleep(1); \
    if ((++_sp & 255u) == 0u) { if (xb_ld(&(bar)[XB_TMO])) break; if (_sp > XB_SPIN_CAP) { atomicAdd(&(bar)[XB_TMO], 1u); break; } } } } while (0)
struct XcdBarrier { unsigned* bar; unsigned x; volatile LAS unsigned* st; };
__device__ __forceinline__ XcdBarrier xcd_barrier_post(unsigned* bar, volatile LAS unsigned* st) {
    XcdBarrier b; b.bar = bar; b.x = xb_xcc_id(); b.st = st;
    if (opaque_tid() == 0) st[3] = xb_add(&bar[XB_XCNT(b.x)], 1u);
    return b;
}
__device__ __forceinline__ void xcd_barrier_complete(unsigned* bar, unsigned x, unsigned& nloc, unsigned& nx) {
    const unsigned G = gridDim.x * gridDim.y * gridDim.z;
    unsigned sum, cnt, mine, sp = 0u;
    for (;;) {
        sum = 0u; cnt = 0u; mine = 0u;
#pragma unroll
        for (unsigned j = 0; j < 16; ++j) { const unsigned c = xb_ld(&bar[XB_XCNT(j)]); sum += c; cnt += (c > 0u) ? 1u : 0u; mine = (j == x) ? c : mine; }
        if (sum == G) break;
        __builtin_amdgcn_s_sleep(1);
        if ((++sp & 255u) == 0u) { if (xb_ld(&bar[XB_TMO])) break; if (sp > XB_SPIN_CAP) { atomicAdd(&bar[XB_TMO], 1u); break; } }
    }
    nloc = mine > 0u ? mine : 1u; nx = cnt > 0u ? cnt : 1u;
}
__device__ __forceinline__ unsigned xcd_census_uniform(unsigned* bar) {
    unsigned ok = (gridDim.x == 256u) ? 1u : 0u;
#pragma unroll
    for (unsigned j = 0; j < 16; ++j) { const unsigned c = xb_ld(&bar[XB_XCNT(j)]); if (c != (j < 8u ? 32u : 0u)) ok = 0u; }
    return ok;
}
__device__ __forceinline__ void xcd_barrier(const XcdBarrier& b) {
    asm volatile("s_waitcnt vmcnt(0)" ::: "memory");
    __syncthreads();
    if (opaque_tid() == 0) {
        unsigned* bar = b.bar;
        __builtin_amdgcn_s_waitcnt(0);
        unsigned nloc = b.st[0], nx = b.st[1];
        if (nloc == 0u) { xcd_barrier_complete(bar, b.x, nloc, nx); b.st[0] = nloc; b.st[1] = nx; b.st[2] = xcd_census_uniform(bar); }
        const unsigned old = xb_add(&bar[XB_XSUB(b.x)], 1u);
        const unsigned gen = old / nloc;
        if (old + 1u == (gen + 1u) * nloc) {
            __builtin_amdgcn_fence(__ATOMIC_RELEASE, "agent");
            asm volatile("s_waitcnt vmcnt(0)" ::: "memory");
            const unsigned og = xb_add(&bar[XB_TOP], 1u);
            const unsigned tg = og / nx;
            if (og + 1u == (tg + 1u) * nx) xb_add(&bar[XB_TOPGEN], 1u);
            else XB_SPIN(xb_ld(&bar[XB_TOPGEN]) == tg, bar);
            __builtin_amdgcn_fence(__ATOMIC_ACQUIRE, "agent");
            xb_add(&bar[XB_XGEN(b.x)], 1u);
            asm volatile("s_waitcnt vmcnt(0)" ::: "memory");
        } else {
            XB_SPIN(xb_ld(&bar[XB_XGEN(b.x)]) == gen, bar);
            __builtin_amdgcn_fence(__ATOMIC_ACQUIRE, "agent");
            asm volatile("s_waitcnt vmcnt(0)" ::: "memory");
        }
    }
    __syncthreads();
}
__device__ __forceinline__ void xcd_local_barrier(const XcdBarrier& b) {
    asm volatile("s_waitcnt vmcnt(0)" ::: "memory");
    __syncthreads();
    if (opaque_tid() == 0) {
        unsigned* bar = b.bar;
        __builtin_amdgcn_s_waitcnt(0);
        const unsigned nloc = b.st[0];
        const unsigned old = xb_add(&bar[XB_LSUB(b.x)], 1u);
        const unsigned gen = old / nloc;
        if (old + 1u == (gen + 1u) * nloc) xb_add(&bar[XB_LGEN(b.x)], 1u);
        else XB_SPIN(xb_ld(&bar[XB_LGEN(b.x)]) == gen, bar);
        __builtin_amdgcn_fence(__ATOMIC_ACQUIRE, "agent");
        asm volatile("s_waitcnt vmcnt(0)" ::: "memory");
    }
    __syncthreads();
}

struct Args { const float* in[29]; float* out; unsigned char* ws; };

__device__ __forceinline__ void transpose_item(const float* __restrict__ W, int K, int N, bf16_t* WT, int mode, LAS float* scr, int item, int lane) {
    const int nblk = N / 32, kb = item / nblk, nb = item % nblk, k0 = 64 * kb, r0 = 32 * nb;
    const int n_ = lane & 31;
    const int rho_ = r0 + n_, T_ = rho_ >> 8, w_ = rho_ & 255;
    const int srccol = (mode == 0) ? rho_ : ((w_ < 128) ? (128 * T_ + w_) : (DFF + 128 * T_ + w_ - 128));
    float tv[32];
#pragma unroll
    for (int i = 0; i < 32; ++i) { const int kk = 2 * i + (lane >> 5); tv[i] = W[(size_t)(k0 + kk) * N + srccol]; }
#pragma unroll
    for (int i = 0; i < 32; ++i) { const int kk = 2 * i + (lane >> 5); scr[kk * 33 + n_] = tv[i]; }
    asm volatile("s_waitcnt lgkmcnt(0)" ::: "memory");
    const int c = lane & 7;
#pragma unroll
    for (int j = 0; j < 4; ++j) { const int n = (lane >> 3) + 8 * j; const LAS float* s = scr + (8 * c) * 33 + n;
        u32x4 o; o.x = cvt_pk_bf16(s[0 * 33], s[1 * 33]); o.y = cvt_pk_bf16(s[2 * 33], s[3 * 33]); o.z = cvt_pk_bf16(s[4 * 33], s[5 * 33]); o.w = cvt_pk_bf16(s[6 * 33], s[7 * 33]);
        *(u32x4*)(WT + (size_t)(r0 + n) * K + k0 + 8 * c) = o; }
    asm volatile("s_waitcnt lgkmcnt(0)" ::: "memory");
}

constexpr int TI0 = 1536, TI1 = 512, TI2 = 1536, TI3 = 512, TI4 = 2816, TI6 = 1408;
constexpr int TR_P0_END = TI0 + TI1;
constexpr int TR_S2_BEG = TR_P0_END, TR_S2_END = TR_S2_BEG + TI2 + TI3;
constexpr int TR_S1_BEG = TR_S2_END, TR_S1_END = TR_S1_BEG + TI4 + TI6;
constexpr int TR_S3_BEG = TR_S1_END, TR_S3_END = TR_S3_BEG + TI4 + TI6;
__device__ __forceinline__ void transpose_dispatch(const Args& a, LAS float* scr, int r, int lane) {
    if (r < TI0) { transpose_item(a.in[14], 1024, 3072, (bf16_t*)(a.ws + WS_WHYIN), 0, scr, r, lane); return; } r -= TI0;
    if (r < TI1) { transpose_item(a.in[25], 1024, 1024, (bf16_t*)(a.ws + WS_WHYOUT), 0, scr, r, lane); return; } r -= TI1;
    if (r < TI2) { transpose_item(a.in[26], 1024, 3072, (bf16_t*)(a.ws + WS_WQKV), 0, scr, r, lane); return; } r -= TI2;
    if (r < TI3) { transpose_item(a.in[28], 1024, 1024, (bf16_t*)(a.ws + WS_WNAOUT), 0, scr, r, lane); return; } r -= TI3;
    if (r < TI4) { transpose_item(a.in[12], 1024, 5632, (bf16_t*)(a.ws + WS_WFFIN), 1, scr, r, lane); return; } r -= TI4;
    if (r < TI6) { transpose_item(a.in[13], DFF, 1024, (bf16_t*)(a.ws + WS_WFFOUT), 0, scr, r, lane); return; } r -= TI6;
    if (r < TI4) { transpose_item(a.in[12] + (size_t)1024 * 5632, 1024, 5632, (bf16_t*)(a.ws + WS_WFFIN) + (size_t)5632 * 1024, 1, scr, r, lane); return; } r -= TI4;
    transpose_item(a.in[13] + (size_t)DFF * 1024, DFF, 1024, (bf16_t*)(a.ws + WS_WFFOUT) + (size_t)1024 * DFF, 0, scr, r, lane);
}
__device__ __forceinline__ void deferred_transposes(const Args& a, LAS unsigned char* lds, int r0, int r1, int slot, int nslots) {
    const int lane = opaque_tid() & 63, wave = opaque_tid() >> 6;
    LAS float* scr = (LAS float*)(lds + wave * 16384);
    for (int r = r0 + slot * 8 + wave; r < r1; r += nslots * 8) transpose_dispatch(a, scr, r, lane);
    __syncthreads();
}

__device__ __forceinline__ void ada_item(const Args& a, LAS unsigned char* lds, int it) {
    const int tid = opaque_tid();
    const int layer = it / 96, n0 = 64 * (it % 96);
    LAS float* sl = (LAS float*)lds;
    LAS float* part = (LAS float*)(lds + 20480);
    const float* cs = a.in[4]; const float* cctx = a.in[5];
    for (int i = tid; i < 5 * 1024; i += NTHR) { const int v = i >> 10, k = i & 1023; const float x = (v == 0) ? cctx[k] : cs[(v - 1) * 1024 + k]; sl[i] = x / (1.0f + expf(-x)); }
    __syncthreads();
    const int ln = tid & 15, kg = tid >> 4;
    const float* w = a.in[6] + ((size_t)layer * 1024 + kg * 32) * 6144 + n0 + 4 * ln;
    f32x4 acc[5];
#pragma unroll
    for (int v = 0; v < 5; ++v) acc[v] = (f32x4){0.f, 0.f, 0.f, 0.f};
#pragma unroll 16
    for (int kk = 0; kk < 32; ++kk) { const f32x4 wv = *(const f32x4*)(w + (size_t)kk * 6144); const int k = kg * 32 + kk;
#pragma unroll
        for (int v = 0; v < 5; ++v) acc[v] += wv * sl[v * 1024 + k]; }
#pragma unroll
    for (int v = 0; v < 5; ++v) *(LAS f32x4*)(part + (kg * 5 + v) * 64 + 4 * ln) = acc[v];
    __syncthreads();
    if (tid < 320) { const int v = tid >> 6, n = tid & 63; float s = a.in[7][layer * 6144 + n0 + n];
        for (int g = 0; g < 32; ++g) s += part[(g * 5 + v) * 64 + n];
        __hip_atomic_store((float*)(a.ws + WS_ADA) + (layer * 5 + v) * 6144 + n0 + n, s, __ATOMIC_RELAXED, __HIP_MEMORY_SCOPE_AGENT); }
    asm volatile("s_waitcnt vmcnt(0)" ::: "memory");
    __syncthreads();
    if (tid == 0 && it < 32) (void)__hip_atomic_fetch_add((unsigned*)(a.ws + WS_BAR) + 1, 1u, __ATOMIC_RELAXED, __HIP_MEMORY_SCOPE_AGENT);
}

__device__ __forceinline__ void filter_item(const Args& a, LAS unsigned char* lds, int it) {
    const int tid = opaque_tid(), lane = tid & 63, wave = tid >> 6;
    int L, pg; bf16_t* R;
    if (it < 32) { L = 256; pg = it; R = (bf16_t*)(a.ws + WS_RF256); } else { L = 1024; pg = it - 32; R = (bf16_t*)(a.ws + WS_RF1024); }
    LAS float* H2 = (LAS float*)lds;
    LAS float* fs = (LAS float*)(lds + 4096) + wave * 128;
    const float* w1 = a.in[17]; const float* b1 = a.in[18]; const float* w2 = a.in[19]; const float* b2 = a.in[20]; const float* w3 = a.in[21];
    const float* fq = a.in[22]; const float* dec = a.in[23]; const float* hb = a.in[24];
    LAS float* w1s = (LAS float*)(lds + 8192);
    LAS float* w2s = (LAS float*)(lds + 8192 + 8448);
    { float t1[5], t2[8];
#pragma unroll
      for (int k = 0; k < 5; ++k) { const int i = tid + k * NTHR; t1[k] = (i < 33 * 64) ? w1[i] : 0.f; }
#pragma unroll
      for (int k = 0; k < 8; ++k) t2[k] = w2[tid + k * NTHR];
#pragma unroll
      for (int k = 0; k < 5; ++k) { const int i = tid + k * NTHR; if (i < 33 * 64) w1s[i] = t1[k]; }
#pragma unroll
      for (int k = 0; k < 8; ++k) w2s[tid + k * NTHR] = t2[k]; }
    __syncthreads();
    {
        const int pl = wave, pos = pg * 8 + pl;
        const float tn = (float)pos / (float)(L - 1);
        const float wang = (6.283185307179586f / (float)L) * (float)pos;
        if (lane < 33) { float f;
            if (lane == 0) f = tn;
            else { const int kb = (lane - 1) & 15; const float band = 1e-4f + (float)kb * ((15.0f - 1e-4f) / 15.0f); const float arg = band * wang; f = (lane <= 16) ? cosf(arg) : sinf(arg); }
            fs[lane] = f; }
        asm volatile("s_waitcnt lgkmcnt(0)" ::: "memory");
        float s = b1[lane];
#pragma unroll 11
        for (int e = 0; e < 33; ++e) s += fs[e] * w1s[e * 64 + lane];
        fs[64 + lane] = sinf(fq[lane] * s);
        asm volatile("s_waitcnt lgkmcnt(0)" ::: "memory");
        float s2 = b2[lane];
#pragma unroll 16
        for (int e = 0; e < 64; ++e) s2 += fs[64 + e] * w2s[e * 64 + lane];
        H2[pl * 64 + lane] = sinf(fq[64 + lane] * s2);
        asm volatile("s_waitcnt lgkmcnt(0)" ::: "memory");
    }
    __syncthreads();
    const f32x4 dc = *(const f32x4*)(dec + 4 * tid);
    {
        f32x4 acc[8];
#pragma unroll
        for (int p = 0; p < 8; ++p) acc[p] = (f32x4){0.f, 0.f, 0.f, 0.f};
#pragma unroll 16
        for (int e = 0; e < 64; ++e) { const f32x4 wv = *(const f32x4*)(w3 + (size_t)e * 2048 + 4 * tid);
#pragma unroll
            for (int p = 0; p < 8; ++p) acc[p] += wv * H2[p * 64 + e]; }
#pragma unroll
        for (int cc = 0; cc < 4; ++cc) { const int c = 4 * tid + cc; const float ad = fabsf(dc[cc]);
            float v8[8];
#pragma unroll
            for (int p = 0; p < 8; ++p) { const float tn = (float)(pg * 8 + p) / (float)(L - 1); v8[p] = acc[p][cc] * (__expf(-tn * ad) + 0.05f); }
            if (c < D) {
                if (pg == 0) v8[0] += hb[c];
                u32x4 w; w.x = cvt_pk_bf16(v8[7], v8[6]); w.y = cvt_pk_bf16(v8[5], v8[4]); w.z = cvt_pk_bf16(v8[3], v8[2]); w.w = cvt_pk_bf16(v8[1], v8[0]);
                *(u32x4*)(R + (size_t)c * 2 * L + L - 8 * (pg + 1)) = w;
            } else {
                bf16_t* row = R + (size_t)(c - D) * 2 * L; const int m0 = L - 1 + 8 * pg;
                if (pg == 0) row[2 * L - 1] = 0; else row[m0] = f2bf(v8[0]);
                *(unsigned*)(row + m0 + 1) = cvt_pk_bf16(v8[1], v8[2]); *(unsigned*)(row + m0 + 3) = cvt_pk_bf16(v8[3], v8[4]); *(unsigned*)(row + m0 + 5) = cvt_pk_bf16(v8[5], v8[6]);
                row[m0 + 7] = f2bf(v8[7]);
            }
        }
    }
    __syncthreads();
}

__device__ __forceinline__ void e1_item(const Args& a, int e) {
    const int tid = opaque_tid(), lane = tid & 63, wave = tid >> 6;
    if (tid == 0) { unsigned* done = (unsigned*)(a.ws + WS_BAR) + 1; unsigned sp = 0u;
        while (__hip_atomic_load(done, __ATOMIC_RELAXED, __HIP_MEMORY_SCOPE_AGENT) < 32u) { __builtin_amdgcn_s_sleep(2); if (++sp > (1u << 20)) break; }
        __builtin_amdgcn_fence(__ATOMIC_ACQUIRE, "agent");
        asm volatile("s_waitcnt vmcnt(0)" ::: "memory"); }
    __syncthreads();
    const float* ada = (const float*)(a.ws + WS_ADA);
    bf16_t* H = (bf16_t*)(a.ws + WS_H);
    const int rowb = 32 * e + 4 * wave;
    const float* av = ada + ((rowb < NPTOK) ? 0 : 1 + ((rowb - NPTOK) >> 10)) * 6144;
    f32x4 sh[2][2], sc[2][2];
#pragma unroll
    for (int j = 0; j < 2; ++j) { const int col = 8 * lane + 512 * j; sh[j][0] = *(const f32x4*)(av + col); sh[j][1] = *(const f32x4*)(av + col + 4); sc[j][0] = *(const f32x4*)(av + 1024 + col); sc[j][1] = *(const f32x4*)(av + 1028 + col); }
#pragma unroll
    for (int i = 0; i < 4; ++i) { const int row = rowb + i;
        const float* src = (row < NPTOK) ? a.in[0] + (size_t)row * D : a.in[1] + (size_t)(row - NPTOK) * D;
#pragma unroll
        for (int j = 0; j < 2; ++j) { const int col = 8 * lane + 512 * j;
            const f32x4 x0 = *(const f32x4*)(src + col), x1 = *(const f32x4*)(src + col + 4);
            const f32x4 y0 = x0 * (sc[j][0] + 1.0f) + sh[j][0], y1 = x1 * (sc[j][1] + 1.0f) + sh[j][1];
            u32x4 w; w.x = cvt_pk_bf16(y0[0], y0[1]); w.y = cvt_pk_bf16(y0[2], y0[3]); w.z = cvt_pk_bf16(y1[0], y1[1]); w.w = cvt_pk_bf16(y1[2], y1[3]);
            *(u32x4*)(H + (size_t)row * D + col) = w; } }
}

__device__ __forceinline__ void p0_prep(const Args& a, LAS unsigned char* lds) {
    const int tid = opaque_tid(), lane = tid & 63, wave = tid >> 6, bx = blockIdx.x, G = gridDim.x;
    LAS float* scr = (LAS float*)(lds + wave * 16384);
    constexpr int NIT = TR_P0_END, NCHUNK = NIT / 8, NE1 = NTOK / 32, NFILT = 160, NPRE = NFILT + 192, NITEMS = NPRE + NCHUNK + NE1;
    static_assert(NIT % 8 == 0, "transpose items in chunks of 8");
    unsigned* ctr = (unsigned*)(a.ws + WS_BAR);
    volatile LAS int* nxt = (volatile LAS int*)(lds + LDS_CTL + 128);
    for (;;) {
        __syncthreads();
        if (tid == 0) *nxt = (int)__hip_atomic_fetch_add(ctr, 1u, __ATOMIC_RELAXED, __HIP_MEMORY_SCOPE_AGENT);
        __syncthreads();
        const int item = *nxt;
        if (item >= NITEMS) break;
        if (item < NFILT) { filter_item(a, lds, item); continue; }
        if (item < NPRE) { ada_item(a, lds, item - NFILT); continue; }
        if (item >= NPRE + NCHUNK) { e1_item(a, item - NPRE - NCHUNK); continue; }
        transpose_dispatch(a, scr, (item - NPRE) * 8 + wave, lane);
    }
    __syncthreads();
}

__device__ __forceinline__ void e1_modulate(const Args& a) {
    const int lane = opaque_tid() & 63, gw = blockIdx.x * NWAVES + (opaque_tid() >> 6), NGW = gridDim.x * NWAVES;
    const float* ada = (const float*)(a.ws + WS_ADA);
    bf16_t* H = (bf16_t*)(a.ws + WS_H);
    for (int row = gw; row < NTOK; row += NGW) {
        const float* src = (row < NPTOK) ? a.in[0] + (size_t)row * D : a.in[1] + (size_t)(row - NPTOK) * D;
        const int v = (row < NPTOK) ? 0 : 1 + ((row - NPTOK) >> 10);
        const float* av = ada + v * 6144;
#pragma unroll
        for (int j = 0; j < 4; ++j) { const int col = 4 * lane + 256 * j;
            const f32x4 x = *(const f32x4*)(src + col), sh = *(const f32x4*)(av + col), sc = *(const f32x4*)(av + 1024 + col);
            const f32x4 y = x * (sc + 1.0f) + sh; u32x2 w; w.x = cvt_pk_bf16(y[0], y[1]); w.y = cvt_pk_bf16(y[2], y[3]);
            *(u32x2*)(H + (size_t)row * D + col) = w; }
    }
}
template <bool FINAL> __device__ __forceinline__ void ln_rows4(const Args& a, const float* lng, const float* lnb, float* xout, const float* adav, int rowbase, const float* bpf, const float* bsf);
template <bool FINAL>
__device__ __forceinline__ void ln_phase(const Args& a, const float* lng, const float* lnb, float* xout, const float* adav  , int vb = -1, const float* bpf = nullptr, const float* bsf = nullptr) {
    if (vb >= 0) { ln_rows4<FINAL>(a, lng, lnb, xout, adav, 1024 * (vb & 7) + 32 * (vb >> 3) + 4 * (opaque_tid() >> 6), bpf, bsf); return; }
    const int lane = opaque_tid() & 63, wv = opaque_tid() >> 6;
    const int gw = (vb >= 0) ? (1024 * (vb & 7) + 32 * (vb >> 3) + 4 * wv) : (int)(blockIdx.x * NWAVES + wv), NGW = (vb >= 0) ? 1 : (int)(gridDim.x * NWAVES);
    const int rend = (vb >= 0) ? gw + 4 : NTOK;
    const bf16_t* P0 = (const bf16_t*)(a.ws + WS_P0); const bf16_t* P1 = (const bf16_t*)(a.ws + WS_P1);
    bf16_t* H = (bf16_t*)(a.ws + WS_H); bf16_t* X = (bf16_t*)(a.ws + WS_X);
    for (int row = gw; row < rend; row += NGW) {
        float v[16]; float s = 0.f;
#pragma unroll
        for (int j = 0; j < 2; ++j) { const int col = 8 * lane + 512 * j;
            const u32x4 p = *(const u32x4*)(P0 + (size_t)row * D + col), q = *(const u32x4*)(P1 + (size_t)row * D + col);
            v[8 * j + 0] = bflo(p.x) + bflo(q.x); v[8 * j + 1] = bfhi(p.x) + bfhi(q.x); v[8 * j + 2] = bflo(p.y) + bflo(q.y); v[8 * j + 3] = bfhi(p.y) + bfhi(q.y);
            v[8 * j + 4] = bflo(p.z) + bflo(q.z); v[8 * j + 5] = bfhi(p.z) + bfhi(q.z); v[8 * j + 6] = bflo(p.w) + bflo(q.w); v[8 * j + 7] = bfhi(p.w) + bfhi(q.w);
            if (bpf) { const float* br = ((row < NPTOK) ? bpf + (size_t)row * D : bsf + (size_t)(row - NPTOK) * D) + col; const f32x4 b0 = *(const f32x4*)br, b1 = *(const f32x4*)(br + 4);
#pragma unroll
                for (int e = 0; e < 4; ++e) { v[8 * j + e] += ALPHA_C * b0[e]; v[8 * j + 4 + e] += ALPHA_C * b1[e]; } }
            else { const u32x4 xb = *(const u32x4*)((const bf16_t*)(a.ws + WS_X) + (size_t)row * D + col);
                v[8 * j + 0] += ALPHA_C * bflo(xb.x); v[8 * j + 1] += ALPHA_C * bfhi(xb.x); v[8 * j + 2] += ALPHA_C * bflo(xb.y); v[8 * j + 3] += ALPHA_C * bfhi(xb.y);
                v[8 * j + 4] += ALPHA_C * bflo(xb.z); v[8 * j + 5] += ALPHA_C * bfhi(xb.z); v[8 * j + 6] += ALPHA_C * bflo(xb.w); v[8 * j + 7] += ALPHA_C * bfhi(xb.w); } }
#pragma unroll
        for (int e = 0; e < 16; ++e) s += v[e];
        const float mean = wave_sum(s) * (1.0f / D); float s2 = 0.f;
#pragma unroll
        for (int e = 0; e < 16; ++e) { v[e] -= mean; s2 += v[e] * v[e]; }
        const float rstd = 1.0f / sqrtf(wave_sum(s2) * (1.0f / D) + LN_EPS_C);
        const int vi = (row < NPTOK) ? 0 : 1 + ((row - NPTOK) >> 10);
#pragma unroll
        for (int j = 0; j < 2; ++j) { const int col = 8 * lane + 512 * j;
            const f32x4 g0 = *(const f32x4*)(lng + col), g1 = *(const f32x4*)(lng + col + 4), b0 = *(const f32x4*)(lnb + col), b1 = *(const f32x4*)(lnb + col + 4);
            f32x4 y0, y1;
#pragma unroll
            for (int e = 0; e < 4; ++e) { y0[e] = v[8 * j + e] * rstd * g0[e] + b0[e]; y1[e] = v[8 * j + 4 + e] * rstd * g1[e] + b1[e]; }
            if (FINAL) { *(f32x4*)(xout + (size_t)row * D + col) = y0; *(f32x4*)(xout + (size_t)row * D + col + 4) = y1; }
            else {
                u32x4 w; w.x = cvt_pk_bf16(y0[0], y0[1]); w.y = cvt_pk_bf16(y0[2], y0[3]); w.z = cvt_pk_bf16(y1[0], y1[1]); w.w = cvt_pk_bf16(y1[2], y1[3]);
                *(u32x4*)(X + (size_t)row * D + col) = w;
                const float* ap = adav + vi * 6144 + col;
                const f32x4 sh0 = *(const f32x4*)(ap), sh1 = *(const f32x4*)(ap + 4), sc0 = *(const f32x4*)(ap + 1024), sc1 = *(const f32x4*)(ap + 1028);
                const f32x4 h0 = y0 * (sc0 + 1.0f) + sh0, h1 = y1 * (sc1 + 1.0f) + sh1;
                u32x4 hw; hw.x = cvt_pk_bf16(h0[0], h0[1]); hw.y = cvt_pk_bf16(h0[2], h0[3]); hw.z = cvt_pk_bf16(h1[0], h1[1]); hw.w = cvt_pk_bf16(h1[2], h1[3]);
                *(u32x4*)(H + (size_t)row * D + col) = hw; }
        }
    }
}


template <bool FINAL>
__device__ __forceinline__ void ln_rows4(const Args& a, const float* lng, const float* lnb, float* xout, const float* adav, int rowbase, const float* bpf, const float* bsf) {
    const int lane = opaque_tid() & 63;
    const bf16_t* P0 = (const bf16_t*)(a.ws + WS_P0); const bf16_t* P1 = (const bf16_t*)(a.ws + WS_P1);
    bf16_t* H = (bf16_t*)(a.ws + WS_H); bf16_t* X = (bf16_t*)(a.ws + WS_X);
    constexpr int RB = 4;
    float v[RB][16]; float mean[RB], rstd[RB];
    const int vi = (rowbase < NPTOK) ? 0 : 1 + ((rowbase - NPTOK) >> 10);
    f32x4 pg[2][2], pb[2][2], psh[2][2], psc[2][2];
#pragma unroll
    for (int j = 0; j < 2; ++j) { const int col = 8 * lane + 512 * j;
        pg[j][0] = *(const f32x4*)(lng + col); pg[j][1] = *(const f32x4*)(lng + col + 4); pb[j][0] = *(const f32x4*)(lnb + col); pb[j][1] = *(const f32x4*)(lnb + col + 4);
        if (!FINAL) { const float* ap = adav + vi * 6144 + col; psh[j][0] = *(const f32x4*)(ap); psh[j][1] = *(const f32x4*)(ap + 4); psc[j][0] = *(const f32x4*)(ap + 1024); psc[j][1] = *(const f32x4*)(ap + 1028); } }
#pragma unroll
    for (int rr = 0; rr < RB; ++rr) { const int row = rowbase + rr;
#pragma unroll
        for (int j = 0; j < 2; ++j) { const int col = 8 * lane + 512 * j;
            const u32x4 p = *(const u32x4*)(P0 + (size_t)row * D + col), q = *(const u32x4*)(P1 + (size_t)row * D + col);
            v[rr][8 * j + 0] = bflo(p.x) + bflo(q.x); v[rr][8 * j + 1] = bfhi(p.x) + bfhi(q.x); v[rr][8 * j + 2] = bflo(p.y) + bflo(q.y); v[rr][8 * j + 3] = bfhi(p.y) + bfhi(q.y);
            v[rr][8 * j + 4] = bflo(p.z) + bflo(q.z); v[rr][8 * j + 5] = bfhi(p.z) + bfhi(q.z); v[rr][8 * j + 6] = bflo(p.w) + bflo(q.w); v[rr][8 * j + 7] = bfhi(p.w) + bfhi(q.w);
            if (bpf) { const float* br = ((row < NPTOK) ? bpf + (size_t)row * D : bsf + (size_t)(row - NPTOK) * D) + col; const f32x4 b0 = *(const f32x4*)br, b1 = *(const f32x4*)(br + 4);
#pragma unroll
                for (int e = 0; e < 4; ++e) { v[rr][8 * j + e] += ALPHA_C * b0[e]; v[rr][8 * j + 4 + e] += ALPHA_C * b1[e]; } }
            else { const u32x4 xb = *(const u32x4*)(X + (size_t)row * D + col);
                v[rr][8 * j + 0] += ALPHA_C * bflo(xb.x); v[rr][8 * j + 1] += ALPHA_C * bfhi(xb.x); v[rr][8 * j + 2] += ALPHA_C * bflo(xb.y); v[rr][8 * j + 3] += ALPHA_C * bfhi(xb.y);
                v[rr][8 * j + 4] += ALPHA_C * bflo(xb.z); v[rr][8 * j + 5] += ALPHA_C * bfhi(xb.z); v[rr][8 * j + 6] += ALPHA_C * bflo(xb.w); v[rr][8 * j + 7] += ALPHA_C * bfhi(xb.w); } } }
#pragma unroll
    for (int rr = 0; rr < RB; ++rr) { float s = 0.f;
#pragma unroll
        for (int e = 0; e < 16; ++e) s += v[rr][e];
        mean[rr] = s; }
#pragma unroll
    for (int o = 1; o < 64; o <<= 1)
#pragma unroll
        for (int rr = 0; rr < RB; ++rr) mean[rr] += __shfl_xor(mean[rr], o);
#pragma unroll
    for (int rr = 0; rr < RB; ++rr) { mean[rr] *= (1.0f / D); float s2 = 0.f;
#pragma unroll
        for (int e = 0; e < 16; ++e) { v[rr][e] -= mean[rr]; s2 += v[rr][e] * v[rr][e]; }
        rstd[rr] = s2; }
#pragma unroll
    for (int o = 1; o < 64; o <<= 1)
#pragma unroll
        for (int rr = 0; rr < RB; ++rr) rstd[rr] += __shfl_xor(rstd[rr], o);
#pragma unroll
    for (int rr = 0; rr < RB; ++rr) { const int row = rowbase + rr;
        const float rs = 1.0f / sqrtf(rstd[rr] * (1.0f / D) + LN_EPS_C);
#pragma unroll
        for (int j = 0; j < 2; ++j) { const int col = 8 * lane + 512 * j;
            const f32x4 g0 = pg[j][0], g1 = pg[j][1], b0 = pb[j][0], b1 = pb[j][1];
            f32x4 y0, y1;
#pragma unroll
            for (int e = 0; e < 4; ++e) { y0[e] = v[rr][8 * j + e] * rs * g0[e] + b0[e]; y1[e] = v[rr][8 * j + 4 + e] * rs * g1[e] + b1[e]; }
            if (FINAL) { *(f32x4*)(xout + (size_t)row * D + col) = y0; *(f32x4*)(xout + (size_t)row * D + col + 4) = y1; }
            else {
                u32x4 w; w.x = cvt_pk_bf16(y0[0], y0[1]); w.y = cvt_pk_bf16(y0[2], y0[3]); w.z = cvt_pk_bf16(y1[0], y1[1]); w.w = cvt_pk_bf16(y1[2], y1[3]);
                *(u32x4*)(X + (size_t)row * D + col) = w;
                const f32x4 sh0 = psh[j][0], sh1 = psh[j][1], sc0 = psc[j][0], sc1 = psc[j][1];
                const f32x4 h0 = y0 * (sc0 + 1.0f) + sh0, h1 = y1 * (sc1 + 1.0f) + sh1;
                u32x4 hw; hw.x = cvt_pk_bf16(h0[0], h0[1]); hw.y = cvt_pk_bf16(h0[2], h0[3]); hw.z = cvt_pk_bf16(h1[0], h1[1]); hw.w = cvt_pk_bf16(h1[2], h1[3]);
                *(u32x4*)(H + (size_t)row * D + col) = hw; }
        }
    }
}

__device__ __forceinline__ void conv3_chunk(const bf16_t* zrow, int s0, int L, float w0, float w1, float w2, float bb, float (&o)[8]) {
    const u32x4 q = *(const u32x4*)(zrow + s0);
    float z[10];
    z[1] = bflo(q.x); z[2] = bfhi(q.x); z[3] = bflo(q.y); z[4] = bfhi(q.y); z[5] = bflo(q.z); z[6] = bfhi(q.z); z[7] = bflo(q.w); z[8] = bfhi(q.w);
    z[0] = (s0 > 0) ? bf2f(zrow[s0 - 1]) : 0.f; z[9] = (s0 + 8 < L) ? bf2f(zrow[s0 + 8]) : 0.f;
#pragma unroll
    for (int e = 0; e < 8; ++e) o[e] = z[e] * w0 + z[e + 1] * w1 + z[e + 2] * w2 + bb;
}
__device__ __forceinline__ void conv3_regs(const u32x4 q, bf16_t prev, bf16_t next, float w0, float w1, float w2, float bb, float (&o)[8]) {
    float z[10];
    z[0] = bf2f(prev); z[1] = bflo(q.x); z[2] = bfhi(q.x); z[3] = bflo(q.y); z[4] = bfhi(q.y); z[5] = bflo(q.z); z[6] = bfhi(q.z); z[7] = bflo(q.w); z[8] = bfhi(q.w); z[9] = bf2f(next);
#pragma unroll
    for (int e = 0; e < 8; ++e) o[e] = z[e] * w0 + z[e + 1] * w1 + z[e + 2] * w2 + bb;
}
template <int L, int NBH>
__device__ __forceinline__ void hyena_item(const Args& a, LAS unsigned char* lds, int d0, int tokbase) {
    constexpr int nA = L / 32, BPT = 32 / nA, NT = NBH * nA / 32, NTOKI = NBH * L;
    static_assert(NT == 2 && NTOKI == 2048, "half-item geometry");
    const int tid = opaque_tid(), lane = tid & 63, wave = tid >> 6;
    const int d = d0 + wave;
    const bf16_t* zT = (const bf16_t*)(a.ws + WS_BIG);
    const bf16_t* R = (const bf16_t*)(a.ws + (L == 256 ? WS_RF256 : WS_RF1024)) + (size_t)d * 2 * L;
    LAS unsigned char* Fr = lds + wave * HY_WSTR;
    LAS unsigned char* Vr = Fr + 8192;
    LAS unsigned* cp = (LAS unsigned*)Fr;
    const float* sw = a.in[15]; const float* sb = a.in[16];
    LAS unsigned char* Xr = Fr + 13312;
    for (int hr1_ = 0; hr1_ <= (int)(HYREP & 1u); ++hr1_) {
    { const u32x4* rd4 = (const u32x4*)R; const unsigned* rd = (const unsigned*)R;
      u32x4 fx[L / 256]; unsigned fy[L / 256];
#pragma unroll
      for (int it = 0; it < L / 256; ++it) { const int q4 = lane + 64 * it; fx[it] = rd4[q4]; fy[it] = (4 * q4 + 4 < L) ? rd[4 * q4 + 4] : 0u; }
#pragma unroll
      for (int it = 0; it < L / 256; ++it) { const int q = 4 * (lane + 64 * it); const u32x4 x = fx[it];
          *(LAS u32x4*)(cp + q) = x;
          u32x4 y; y.x = (x.x >> 16) | (x.y << 16); y.y = (x.y >> 16) | (x.z << 16); y.z = (x.z >> 16) | (x.w << 16); y.w = (x.w >> 16) | (fy[it] << 16);
          *(LAS u32x4*)(cp + L + q) = y; } }
    { const float v0 = sw[2048 + d], v1 = sw[3072 + 2048 + d], v2 = sw[6144 + 2048 + d], vb = sb[2048 + d];
      const float x0 = sw[1024 + d], x1 = sw[3072 + 1024 + d], x2 = sw[6144 + 1024 + d], xb = sb[1024 + d];
      const float o0 = sw[d], o1 = sw[3072 + d], o2 = sw[6144 + d], ob = sb[d];
      const bf16_t* zv = zT + (size_t)(2048 + d) * NTOK + tokbase; const bf16_t* zx = zT + (size_t)(1024 + d) * NTOK + tokbase; const bf16_t* zo = zT + (size_t)d * NTOK + tokbase;
      constexpr int NI = NTOKI / 8 / 64;
      u32x4 rv[NI], rx[NI], ro[NI]; bf16_t pv[NI], nv[NI], px[NI], nx[NI], po[NI], no[NI];
#pragma unroll
      for (int it = 0; it < NI; ++it) { const int idx = lane + 64 * it; const int t0 = idx * 8, s0 = t0 % L;
          rv[it] = *(const u32x4*)(zv + t0); rx[it] = *(const u32x4*)(zx + t0); ro[it] = *(const u32x4*)(zo + t0);
          const bool hp = s0 > 0, hn = s0 + 8 < L;
          pv[it] = hp ? zv[t0 - 1] : (bf16_t)0; nv[it] = hn ? zv[t0 + 8] : (bf16_t)0;
          px[it] = hp ? zx[t0 - 1] : (bf16_t)0; nx[it] = hn ? zx[t0 + 8] : (bf16_t)0;
          po[it] = hp ? zo[t0 - 1] : (bf16_t)0; no[it] = hn ? zo[t0 + 8] : (bf16_t)0; }
#pragma unroll
      for (int it = 0; it < NI; ++it) { const int idx = lane + 64 * it; const int t0 = idx * 8;
          float cv[8], cx[8], co[8];
          conv3_regs(rv[it], pv[it], nv[it], v0, v1, v2, vb, cv); conv3_regs(rx[it], px[it], nx[it], x0, x1, x2, xb, cx); conv3_regs(ro[it], po[it], no[it], o0, o1, o2, ob, co);
          u32x4 w; w.x = cvt_pk_bf16(cv[0] * cx[0], cv[1] * cx[1]); w.y = cvt_pk_bf16(cv[2] * cx[2], cv[3] * cx[3]); w.z = cvt_pk_bf16(cv[4] * cx[4], cv[5] * cx[5]); w.w = cvt_pk_bf16(cv[6] * cx[6], cv[7] * cx[7]);
          *(LAS u32x4*)(Vr + (t0 >> 5) * 80 + (t0 & 31) * 2) = w;
          u32x4 wo; wo.x = cvt_pk_bf16(co[0], co[1]); wo.y = cvt_pk_bf16(co[2], co[3]); wo.z = cvt_pk_bf16(co[4], co[5]); wo.w = cvt_pk_bf16(co[6], co[7]);
          *(LAS u32x4*)(Xr + (size_t)t0 * 2) = wo; } }
    __syncthreads(); }
    __syncthreads();
    f32x16 acc[NT];
#pragma unroll
    for (int q = 0; q < NT; ++q)
#pragma unroll
        for (int e = 0; e < 16; ++e) acc[q][e] = 0.f;
    for (int hr2_ = 0; hr2_ <= (int)((HYREP >> 1) & 1u); ++hr2_) {
    if (hr2_ == 1) { _Pragma("unroll") for (int q = 0; q < NT; ++q) _Pragma("unroll") for (int e = 0; e < 16; ++e) acc[q][e] *= 0.5f; }
    {
        const int i = lane & 31, h = lane >> 5, p = 1 - (i & 1);
        const int n = lane & 31, aidx = n % nA, bsub = n / nA;
        LAS const unsigned* cpp = cp + p * L;
        LAS const unsigned char* zero16 = lds + HY_ZERO;
        LAS const unsigned char* vlane = Vr + bsub * nA * 80 + 16 * h;
        const int mbase = (L - 1) - i + 8 * h;
        LAS const unsigned* ap = cpp + (mbase >> 1) + 16 * (nA - 1);
        int ab = aidx + (nA - 1);
        LAS const unsigned char* vr = vlane + ab * 80;
#pragma unroll 1
        for (int it = 0; it < 2 * nA - 1; ++it) {
            const bool ok = (ab >= 0) && (ab < nA);
            LAS const unsigned char* vrow = ok ? vr : zero16;
            const int vstep = ok ? BPT * nA * 80 : 0, jstep = ok ? 32 : 0;
            u32x4 af0, af1; af0.x = ap[0]; af0.y = ap[1]; af0.z = ap[2]; af0.w = ap[3]; af1.x = ap[8]; af1.y = ap[9]; af1.z = ap[10]; af1.w = ap[11];
            u32x4 bf[NT][2];
#pragma unroll
            for (int q = 0; q < NT; ++q) { bf[q][0] = *(LAS const u32x4*)(vrow + q * vstep); bf[q][1] = *(LAS const u32x4*)(vrow + q * vstep + jstep); }
#pragma unroll
            for (int q = 0; q < NT; ++q) {
                acc[q] = __builtin_amdgcn_mfma_f32_32x32x16_bf16(__builtin_bit_cast(bf16x8, af0), __builtin_bit_cast(bf16x8, bf[q][0]), acc[q], 0, 0, 0);
                acc[q] = __builtin_amdgcn_mfma_f32_32x32x16_bf16(__builtin_bit_cast(bf16x8, af1), __builtin_bit_cast(bf16x8, bf[q][1]), acc[q], 0, 0, 0); }
            ap -= 16; ab -= 1; vr -= 80;
        }
    }
    }
    if ((HYREP >> 1) & 1u) { _Pragma("unroll") for (int q = 0; q < NT; ++q) _Pragma("unroll") for (int e = 0; e < 16; ++e) acc[q][e] *= (2.0f / 3.0f); }
    __syncthreads();
    { const int h = lane >> 5, n = lane & 31, aidx = n % nA, bsub = n / nA;
#pragma unroll
      for (int q = 0; q < NT; ++q) { const int b = q * BPT + bsub;
#pragma unroll
          for (int rg = 0; rg < 4; ++rg) { const int t = 32 * aidx + 8 * rg + 4 * h; const int off = (b * L + t) * 2;
              const u32x2 xc = *(LAS const u32x2*)(Xr + off);
              u32x2 w; w.x = cvt_pk_bf16(acc[q][4 * rg] * bflo(xc.x), acc[q][4 * rg + 1] * bfhi(xc.x)); w.y = cvt_pk_bf16(acc[q][4 * rg + 2] * bflo(xc.y), acc[q][4 * rg + 3] * bfhi(xc.y));
              *(LAS u32x2*)(Vr + ((b * L + t) >> 5) * 80 + (t & 31) * 2) = w; } } }
    __syncthreads();
    for (int hr3_ = 0; hr3_ <= (int)((HYREP >> 2) & 1u); ++hr3_)
    { bf16_t* Y = (bf16_t*)(a.ws + WS_Y);
#pragma unroll
      for (int it = 0; it < NTOKI / NTHR; ++it) { const int tok = tid + it * NTHR; unsigned short e[8];
#pragma unroll
          for (int w = 0; w < 8; ++w) e[w] = *(LAS const unsigned short*)(lds + w * HY_WSTR + 8192 + (tok >> 5) * 80 + (tok & 31) * 2);
          u32x4 o; o.x = e[0] | ((unsigned)e[1] << 16); o.y = e[2] | ((unsigned)e[3] << 16); o.z = e[4] | ((unsigned)e[5] << 16); o.w = e[6] | ((unsigned)e[7] << 16);
          *(u32x4*)(Y + (size_t)(tokbase + tok) * D + d0) = o; } }
    __syncthreads();
}

constexpr int AT_KP = 144, AT_VP = 528;
constexpr int AT_K_OFF = 2048, AT_V_OFF = AT_K_OFF + 256 * AT_KP;
constexpr int AT_LVP = 912;
constexpr int AT_LK_OFF = 2048, AT_LV_OFF = 65536;
__device__ __forceinline__ void attn_stage_kv(LAS unsigned char* lds, const char* ksrc, const char* vsrc, int vpitch) {
    const int tid = opaque_tid();
    u32x4 kv[4], vv[4];
#pragma unroll
    for (int k = 0; k < 4; ++k) { const int p = tid + NTHR * k; kv[k] = *(const u32x4*)(ksrc + (size_t)p * 16); vv[k] = *(const u32x4*)(vsrc + (size_t)(p >> 5) * vpitch + (p & 31) * 16); }
#pragma unroll
    for (int k = 0; k < 4; ++k) { const int p = tid + NTHR * k;
        *(LAS u32x4*)(lds + AT_K_OFF + (p >> 3) * AT_KP + (p & 7) * 16) = kv[k];
        *(LAS u32x4*)(lds + AT_V_OFF + (p >> 5) * AT_VP + (p & 31) * 16) = vv[k]; }
}
template <bool FROM_LDS, bool MASK>
__device__ __forceinline__ void attn_chunk(f32x4 (&O)[4], float& m_run, float& sum, const bf16x8 q0, const bf16x8 q1,
                                           const char* kb, const char* vb, int kseg, int vseg, int vrow16, unsigned k0o, unsigned k1o, unsigned vo,
                                           LAS const unsigned char* lk, LAS const unsigned char* lv,
                                           LAS const float* rb, int band0, int g, int qc, int win0) {
    f32x4 S[4][2];
    bf16x8 Vf[4][4];
#pragma unroll
    for (int s4 = 0; s4 < 2; ++s4)
#pragma unroll
        for (int db = 0; db < 4; ++db) {
            if (!FROM_LDS) Vf[s4][db] = *(const bf16x8*)(vb + (size_t)s4 * vseg + (size_t)db * vrow16 + vo); }
#pragma unroll
    for (int s4 = 0; s4 < 4; ++s4) {
        bf16x8 a00, a01, a10, a11;
        if (FROM_LDS) { LAS const unsigned char* ks = lk + s4 * kseg;
            a00 = *(LAS const bf16x8*)(ks); a01 = *(LAS const bf16x8*)(ks + 64); a10 = *(LAS const bf16x8*)(ks + 4 * AT_KP); a11 = *(LAS const bf16x8*)(ks + 4 * AT_KP + 64); }
        else { const char* ks = kb + (size_t)s4 * kseg;
            a00 = *(const bf16x8*)(ks + k0o); a01 = *(const bf16x8*)(ks + k0o + 64); a10 = *(const bf16x8*)(ks + k1o); a11 = *(const bf16x8*)(ks + k1o + 64); }
        f32x4 c0 = (f32x4){0.f, 0.f, 0.f, 0.f}, c1 = (f32x4){0.f, 0.f, 0.f, 0.f};
        c0 = __builtin_amdgcn_mfma_f32_16x16x32_bf16(a00, q0, c0, 0, 0, 0);
        c0 = __builtin_amdgcn_mfma_f32_16x16x32_bf16(a01, q1, c0, 0, 0, 0);
        c1 = __builtin_amdgcn_mfma_f32_16x16x32_bf16(a10, q0, c1, 0, 0, 0);
        c1 = __builtin_amdgcn_mfma_f32_16x16x32_bf16(a11, q1, c1, 0, 0, 0);
        S[s4][0] = c0; S[s4][1] = c1;
        if (FROM_LDS) asm volatile("" ::: "memory");
    }
    if (!FROM_LDS) {
        asm volatile("" ::: "memory");
#pragma unroll
        for (int s4 = 2; s4 < 4; ++s4)
#pragma unroll
            for (int db = 0; db < 4; ++db) Vf[s4][db] = *(const bf16x8*)(vb + (size_t)s4 * vseg + (size_t)db * vrow16 + vo);
    }
    if (MASK) {
#pragma unroll
        for (int s4 = 0; s4 < 4; ++s4) { LAS const float* rr = rb + s4 * 31;
#pragma unroll
            for (int t = 0; t < 2; ++t)
#pragma unroll
                for (int e = 0; e < 4; ++e) { const int kc = band0 + 8 * g + 4 * t + e; const bool ok = (kc >= win0) && (kc < win0 + 16);
                    const int dc = min(max(kc - qc + 15, 0), 30);
                    S[s4][t][e] = ok ? S[s4][t][e] + rr[dc] : -INFINITY; } }
    }
    float mx = -INFINITY;
#pragma unroll
    for (int s4 = 0; s4 < 4; ++s4)
#pragma unroll
        for (int t = 0; t < 2; ++t)
#pragma unroll
            for (int e = 0; e < 4; ++e) mx = fmaxf(mx, S[s4][t][e]);
    mx = fmaxf(mx, __shfl_xor(mx, 16)); mx = fmaxf(mx, __shfl_xor(mx, 32));
    const float mnew = fmaxf(m_run, mx);
    const float scl = __builtin_amdgcn_exp2f((m_run - mnew) * 1.4426950408889634f);
    m_run = mnew;
    float ps = 0.f;
#pragma unroll
    for (int s4 = 0; s4 < 4; ++s4)
#pragma unroll
        for (int t = 0; t < 2; ++t)
#pragma unroll
            for (int e = 0; e < 4; ++e) { const float p = __builtin_amdgcn_exp2f((S[s4][t][e] - mnew) * 1.4426950408889634f); S[s4][t][e] = p; ps += p; }
    ps += __shfl_xor(ps, 16); ps += __shfl_xor(ps, 32);
    sum = sum * scl + ps;
#pragma unroll
    for (int db = 0; db < 4; ++db) O[db] = O[db] * scl;
#pragma unroll
    for (int s4 = 0; s4 < 4; ++s4) {
        u32x4 pw; pw.x = cvt_pk_bf16(S[s4][0][0], S[s4][0][1]); pw.y = cvt_pk_bf16(S[s4][0][2], S[s4][0][3]); pw.z = cvt_pk_bf16(S[s4][1][0], S[s4][1][1]); pw.w = cvt_pk_bf16(S[s4][1][2], S[s4][1][3]);
        const bf16x8 pf = __builtin_bit_cast(bf16x8, pw);
#pragma unroll
        for (int db = 0; db < 4; ++db) { if (FROM_LDS) Vf[s4][db] = *(LAS const bf16x8*)(lv + db * vrow16 + s4 * vseg);
            O[db] = __builtin_amdgcn_mfma_f32_16x16x32_bf16(Vf[s4][db], pf, O[db], 0, 0, 0); }
        if (FROM_LDS) asm volatile("" ::: "memory");
    }
    asm volatile("" ::: "memory");
}

__device__ __forceinline__ void attn_ctx_tile(const Args& a, LAS unsigned char* lds, int b, int h, int qt, int lane) {
    const char* BB = (const char*)(a.ws + WS_BIG);
    bf16_t* Y = (bf16_t*)(a.ws + WS_Y);
    const int ql = lane & 15, g = lane >> 4;
    const int qtok0 = b * LP + qt * 16;
    const char* qb = BB + (BQ_OFF + (size_t)qtok0 * D + h * HD) * 2;
    const int ci0 = 8 * (ql >> 2) + (ql & 3);
    const bf16x8 q0 = *(const bf16x8*)(qb + (unsigned)((ql * D + 8 * g) * 2)), q1 = *(const bf16x8*)(qb + (unsigned)((ql * D + 8 * g) * 2) + 64);
    LAS const unsigned char* lk = lds + AT_K_OFF + ci0 * AT_KP + 16 * g;
    LAS const unsigned char* lv = lds + AT_V_OFF + ql * AT_VP + 16 * g;
    float m_run = -INFINITY, sum = 0.f;
    f32x4 O[4];
#pragma unroll
    for (int db = 0; db < 4; ++db) O[db] = (f32x4){0.f, 0.f, 0.f, 0.f};
#pragma unroll 1
    for (int c = 0; c < 2; ++c)
        attn_chunk<true, false>(O, m_run, sum, q0, q1, nullptr, nullptr, 32 * AT_KP, 64, 16 * AT_VP, 0u, 0u, 0u, lk + c * 128 * AT_KP, lv + c * 256, (LAS const float*)lds, 0, g, 0, 0);
    const float inv = 1.0f / sum;
    bf16_t* op = Y + (size_t)(qtok0 + ql) * D + h * HD + 4 * g;
#pragma unroll
    for (int db = 0; db < 4; ++db) { u32x2 w; w.x = cvt_pk_bf16(O[db][0] * inv, O[db][1] * inv); w.y = cvt_pk_bf16(O[db][2] * inv, O[db][3] * inv); *(u32x2*)(op + db * 16) = w; }
}

__device__ __forceinline__ void attn_stage_local(const Args& a, LAS unsigned char* lds, int b, int h, int rowmin, int nrows, int cbase) {
    const int tid = opaque_tid();
    const char* BB = (const char*)(a.ws + WS_BIG);
    const char* ks = BB + (BK_OFF + (size_t)NPTOK * D + ((size_t)(b * NH + h) * LSQ + rowmin * 64 + cbase) * HD) * 2;
    const char* vs = BB + (BVS_OFF + ((size_t)(b * NH + h) * HD) * VPS + rowmin * 64 + cbase) * 2;
    const int total = nrows * 320, n5 = nrows * 5;
    { u32x4 kv[7];
#pragma unroll
      for (int k = 0; k < 7; ++k) { const int p = tid + NTHR * k;
          if (p < total) { const int kr = p / 320, rem = p - kr * 320; kv[k] = *(const u32x4*)(ks + (size_t)kr * (64 * 128) + rem * 16); } }
#pragma unroll
      for (int k = 0; k < 7; ++k) { const int p = tid + NTHR * k;
          if (p < total) { const int kr = p / 320, rem = p - kr * 320, key = rem >> 3, c16 = rem & 7; *(LAS u32x4*)(lds + AT_LK_OFF + (kr * 40 + key) * AT_KP + c16 * 16) = kv[k]; } } }
    asm volatile("" ::: "memory");
    { u32x4 vv[7];
#pragma unroll
      for (int k = 0; k < 7; ++k) { const int p = tid + NTHR * k;
          if (p < total) { const int d = p / n5, rm = p - d * n5, kr2 = rm / 5, c16 = rm - kr2 * 5; vv[k] = *(const u32x4*)(vs + (size_t)d * (VPS * 2) + kr2 * 128 + c16 * 16); } }
#pragma unroll
      for (int k = 0; k < 7; ++k) { const int p = tid + NTHR * k;
          if (p < total) { const int d = p / n5, rm = p - d * n5, kr2 = rm / 5, c16v = rm - kr2 * 5; *(LAS u32x4*)(lds + AT_LV_OFF + d * AT_LVP + kr2 * 80 + c16v * 16) = vv[k]; } } }
}

__device__ __forceinline__ void attn_latent_unit(const Args& a, LAS unsigned char* lds, int b, int h, int i4, int lane, int wave) {
    const char* BB = (const char*)(a.ws + WS_BIG);
    bf16_t* Y = (bf16_t*)(a.ws + WS_Y);
    LAS float* rpbh = (LAS float*)lds;
    const int tid = opaque_tid();
    const int rowmin = min(max(4 * i4 - 4, 0), 8), rowmax = min(max(4 * i4 - 1, 0), 8) + 7, nrows = rowmax - rowmin + 1;
    const int r = 4 * i4 + (wave >> 1), row0 = min(max(r - 4, 0), 8);
    const int ql = lane & 15, g = lane >> 4, ci0 = 8 * (ql >> 2) + (ql & 3);
    f32x4 O[2][4]; float m_run[2], sum[2];
#pragma unroll
    for (int pr = 0; pr < 2; ++pr) {
        const int j = 2 * pr + (wave & 1), cbase = 24 * pr, band0 = min(max(16 * j - 8, 0), 32), off = band0 - cbase;
        __syncthreads();
        if (pr == 0) { for (int i = tid; i < 465; i += NTHR) rpbh[i] = a.in[27][h * 465 + i]; }
        attn_stage_local(a, lds, b, h, rowmin, nrows, cbase);
        __syncthreads();
        const int qtok0 = NPTOK + b * LSQ + r * 64 + j * 16;
        const char* qb = BB + (BQ_OFF + (size_t)qtok0 * D + h * HD) * 2;
        const bf16x8 q0 = *(const bf16x8*)(qb + (unsigned)((ql * D + 8 * g) * 2)), q1 = *(const bf16x8*)(qb + (unsigned)((ql * D + 8 * g) * 2) + 64);
        m_run[pr] = -INFINITY; sum[pr] = 0.f;
#pragma unroll
        for (int db = 0; db < 4; ++db) O[pr][db] = (f32x4){0.f, 0.f, 0.f, 0.f};
        const int kl0 = (row0 - rowmin) * 40 + off;
        LAS const unsigned char* lk = lds + AT_LK_OFF + (kl0 + ci0) * AT_KP + 16 * g;
        LAS const unsigned char* lv = lds + AT_LV_OFF + ql * AT_LVP + (kl0 + 8 * g) * 2;
        const int qc = 16 * j + ql, win0 = min(max(qc - 8, 0), 48);
        LAS const float* rb = rpbh + (row0 - r + 7) * 31;
#pragma unroll 1
        for (int c = 0; c < 2; ++c)
            attn_chunk<true, true>(O[pr], m_run[pr], sum[pr], q0, q1, nullptr, nullptr, 40 * AT_KP, 80, 16 * AT_LVP, 0u, 0u, 0u,
                                   lk + c * 4 * 40 * AT_KP, lv + c * 4 * 80, rb + c * 4 * 31, band0, g, qc, win0);
    }
    __syncthreads();
    attn_stage_kv(lds, (const char*)(a.ws + WS_CK) + (size_t)(b * NH + h) * 256 * HD * 2, (const char*)(a.ws + WS_CVT) + (size_t)(b * NH + h) * HD * CVP * 2, CVP * 2);
    __syncthreads();
    {
        LAS const unsigned char* lk = lds + AT_K_OFF + ci0 * AT_KP + 16 * g;
        LAS const unsigned char* lv = lds + AT_V_OFF + ql * AT_VP + 16 * g;
#pragma unroll
        for (int pr = 0; pr < 2; ++pr) {
            const int j = 2 * pr + (wave & 1);
            const int qtok0 = NPTOK + b * LSQ + r * 64 + j * 16;
            const char* qb = BB + (BQ_OFF + (size_t)qtok0 * D + h * HD) * 2;
            const bf16x8 q0 = *(const bf16x8*)(qb + (unsigned)((ql * D + 8 * g) * 2)), q1 = *(const bf16x8*)(qb + (unsigned)((ql * D + 8 * g) * 2) + 64);
#pragma unroll 1
            for (int c = 0; c < 2; ++c)
                attn_chunk<true, false>(O[pr], m_run[pr], sum[pr], q0, q1, nullptr, nullptr, 32 * AT_KP, 64, 16 * AT_VP, 0u, 0u, 0u, lk + c * 128 * AT_KP, lv + c * 256, rpbh, 0, g, 0, 0);
            const float inv = 1.0f / sum[pr];
            bf16_t* op = Y + (size_t)(qtok0 + ql) * D + h * HD + 4 * g;
#pragma unroll
            for (int db = 0; db < 4; ++db) { u32x2 w; w.x = cvt_pk_bf16(O[pr][db][0] * inv, O[pr][db][1] * inv); w.y = cvt_pk_bf16(O[pr][db][2] * inv, O[pr][db][3] * inv); *(u32x2*)(op + db * 16) = w; }
        }
    }
}

__device__ __forceinline__ void attn_phase(const Args& a, LAS unsigned char* lds) {
    const int tid = opaque_tid(), lane = tid & 63, wave = __builtin_amdgcn_readfirstlane(tid >> 6), bx = blockIdx.x, G = gridDim.x;
    const int vcu = (G % 8 == 0) ? (bx % 8) * (G / 8) + bx / 8 : bx;
    const char* BB = (const char*)(a.ws + WS_BIG);
    for (int u = vcu; u < 256; u += G) { const int bh = u >> 2; attn_latent_unit(a, lds, bh >> 4, bh & 15, u & 3, lane, wave); }
    for (int u = vcu; u < 256; u += G) {
        const int b = u >> 4, h = u & 15;
        __syncthreads();
        attn_stage_kv(lds, BB + (BK_OFF + (size_t)u * LP * HD) * 2, BB + (BV_OFF + (size_t)u * HD * VPP) * 2, VPP * 2);
        __syncthreads();
#pragma unroll 1
        for (int tt = 0; tt < 2; ++tt) attn_ctx_tile(a, lds, b, h, 2 * wave + tt, lane);
    }
    __syncthreads();
}

__device__ __forceinline__ void cache_convert(const Args& a, int slot, int nslots) {
    const int tid = opaque_tid();
    const int gt = slot * NTHR + tid, NGT = nslots * NTHR;
    for (int i = gt; i < 131072; i += NGT) {
        const f32x4 x0 = *(const f32x4*)(a.in[2] + (size_t)i * 8), x1 = *(const f32x4*)(a.in[2] + (size_t)i * 8 + 4);
        u32x4 o; o.x = cvt_pk_bf16(x0[0], x0[1]); o.y = cvt_pk_bf16(x0[2], x0[3]); o.z = cvt_pk_bf16(x1[0], x1[1]); o.w = cvt_pk_bf16(x1[2], x1[3]);
        *(u32x4*)((bf16_t*)(a.ws + WS_CK) + (size_t)i * 8) = o;
        const int d = i & 63, sg = (i >> 6) & 31, bh = i >> 11;
        const float* src = a.in[3] + ((size_t)bh * 256 + 8 * sg) * 64 + d;
        u32x4 p; p.x = cvt_pk_bf16(src[0], src[64]); p.y = cvt_pk_bf16(src[128], src[192]); p.z = cvt_pk_bf16(src[256], src[320]); p.w = cvt_pk_bf16(src[384], src[448]);
        *(u32x4*)((bf16_t*)(a.ws + WS_CVT) + ((size_t)bh * 64 + d) * CVP + 8 * sg) = p;
    }
}

#ifndef PHASES
#define PHASES 0xFFFFFFFFu
#endif
#define PH(k) ((PHASES >> (k)) & 1u)
#ifndef REP
#define REP 0x0u
#endif
#ifndef HYREP
#define HYREP 0x0u
#endif
#ifndef XSYNC
#define XSYNC 0
#endif
#define RP(k) for (int rep_ = 0; rep_ <= (int)((REP >> (k)) & 1u); ++rep_)
__global__ void __launch_bounds__(NTHR, 2) fwd_megakernel(Args a) {
    extern __shared__ __attribute__((aligned(16))) unsigned char lds_raw[];
    LAS unsigned char* lds = (LAS unsigned char*)lds_raw;
    cg::grid_group grid = cg::this_grid();
    if (a.ws == nullptr) grid.sync();
    if (opaque_tid() < 64) ((volatile LAS unsigned*)(lds + LDS_CTL))[opaque_tid()] = 0u;
    __syncthreads();
    const XcdBarrier xbar = xcd_barrier_post((unsigned*)(a.ws + WS_BAR), (volatile LAS unsigned*)(lds + LDS_CTL));
#define GSYNC() xcd_barrier(xbar)
#define LSYNC() do { if (xl_ok) xcd_local_barrier(xbar); else xcd_barrier(xbar); } while (0)
#define IDLE_DEFER(ntot, r0, r1, cid) do { const int rounds_ = ((ntot) + G - 1) / G, nidle_ = rounds_ * G - (ntot); \
    if (nidle_ > 0) { if (cid >= G - nidle_) deferred_transposes(a, lds, r0, r1, cid - (G - nidle_), nidle_); } else deferred_transposes(a, lds, r0, r1, cid, G); } while (0)
    const int G = gridDim.x, bx = blockIdx.x;
    unsigned char* ws = a.ws;
    const float* ada = (const float*)(ws + WS_ADA);
    bf16_t* H = (bf16_t*)(ws + WS_H); bf16_t* Yb = (bf16_t*)(ws + WS_Y);
    bf16_t* X = (bf16_t*)(ws + WS_X); bf16_t* P0 = (bf16_t*)(ws + WS_P0); bf16_t* P1 = (bf16_t*)(ws + WS_P1);
    bf16_t* BIG = (bf16_t*)(ws + WS_BIG);

    RP(0) { if (PH(0)) { p0_prep(a, lds); }
      GSYNC(); }
    const unsigned xl_ok = (unsigned)__builtin_amdgcn_readfirstlane((int)xbar.st[2]);
    const int vb = xl_ok ? __builtin_amdgcn_readfirstlane((int)(xbar.st[3] * 8u + xbar.x)) : bx;
    const int vbln = xl_ok ? vb : -1;

    RP(2) { if (PH(2)) { { pg8::Gemm g{(const bf16_t*)(ws + WS_WHYIN), H, 1024, 1024}; pg8::Order S; S.init(3072, NTOK, 1, G, bx);
      pg8::EpiBf16T E{BIG, NTOK}; pg8::gemm_phase(lds, g, S, E); }
      { const int nidle_c = 2 * G - 384; if (nidle_c > 0 && nidle_c <= G) { if (bx >= G - nidle_c) cache_convert(a, bx - (G - nidle_c), nidle_c); } else cache_convert(a, bx, G); }
      IDLE_DEFER(384, TR_S1_BEG, TR_S1_END, bx); }
      GSYNC(); }
    RP(3) { if (PH(3)) { { for (int it = bx; it < 256; it += G) { hyena_item<1024, 2>(a, lds, 8 * (it >> 1), NPTOK + 2048 * (it & 1)); hyena_item<256, 8>(a, lds, 8 * (it >> 1), 2048 * (it & 1)); } } }
      GSYNC(); }
    RP(4) { if (PH(4)) { { pg8::Gemm g{Yb, (const bf16_t*)(ws + WS_WHYOUT), 512, 1024}; pg8::Order S; S.init(NTOK, 1024, 2, G, vb);
      pg8::EpiRes<true> E{a.in[0], a.in[1], ada + 2048, P0, P1}; pg8::gemm_phase(lds, g, S, E); } }
      LSYNC(); }
    RP(5) { if (PH(5)) { ln_phase<false>(a, a.in[8], a.in[9], nullptr, ada + 3072, vbln, a.in[0], a.in[1]); }
      LSYNC(); }
    RP(6) { if (PH(6)) { { pg8::Gemm g{H, (const bf16_t*)(ws + WS_WFFIN), 1024, 1024}; pg8::Order S; S.init(NTOK, 5632, 1, G, vb);
      pg8::EpiSwiglu E{BIG}; pg8::gemm_phase(lds, g, S, E); }
      IDLE_DEFER(704, TR_S2_BEG, TR_S2_END, vb); }
      LSYNC(); }
    RP(7) { if (PH(7)) { { pg8::Gemm g{BIG, (const bf16_t*)(ws + WS_WFFOUT), 1408, DFF}; pg8::Order S; S.init(NTOK, 1024, 2, G, vb);
      pg8::EpiRes<false> E{X, X + (size_t)NPTOK * D, ada + 5120, P0, P1}; pg8::gemm_phase(lds, g, S, E); } }
      LSYNC(); }
    RP(8) { if (PH(8)) { ln_phase<false>(a, a.in[10], a.in[11], nullptr, ada + 5 * 6144, vbln);   }
      GSYNC(); }

    for (int xs_ = 0; xs_ < XSYNC; ++xs_) GSYNC();
    RP(9) { if (PH(9)) { { pg8::Gemm g{H, (const bf16_t*)(ws + WS_WQKV), 1024, 1024}; pg8::Order S; S.init(NTOK, 3072, 1, G, bx);
      pg8::EpiQKV E{BIG, a.out + (size_t)NTOK * D, a.out + (size_t)NTOK * D + (size_t)NPTOK * D}; pg8::gemm_phase(lds, g, S, E); }
      IDLE_DEFER(384, TR_S3_BEG, TR_S3_END, bx); }
      GSYNC(); }
    RP(10) { if (PH(10)) { attn_phase(a, lds); }
      GSYNC(); }
    RP(11) { if (PH(11)) { { pg8::Gemm g{Yb, (const bf16_t*)(ws + WS_WNAOUT), 512, 1024}; pg8::Order S; S.init(NTOK, 1024, 2, G, vb);
      pg8::EpiRes<false> E{X, X + (size_t)NPTOK * D, ada + 5 * 6144 + 2048, P0, P1}; pg8::gemm_phase(lds, g, S, E); } }
      LSYNC(); }
    RP(12) { if (PH(12)) { ln_phase<false>(a, a.in[8] + D, a.in[9] + D, nullptr, ada + 5 * 6144 + 3072, vbln); }
      LSYNC(); }
    RP(13) { if (PH(13)) { { pg8::Gemm g{H, (const bf16_t*)(ws + WS_WFFIN) + (size_t)5632 * 1024, 1024, 1024}; pg8::Order S; S.init(NTOK, 5632, 1, G, vb);
      pg8::EpiSwiglu E{BIG}; pg8::gemm_phase(lds, g, S, E); } }
      LSYNC(); }
    RP(14) { if (PH(14)) { { pg8::Gemm g{BIG, (const bf16_t*)(ws + WS_WFFOUT) + (size_t)1024 * DFF, 1408, DFF}; pg8::Order S; S.init(NTOK, 1024, 2, G, vb);
      pg8::EpiRes<false> E{X, X + (size_t)NPTOK * D, ada + 5 * 6144 + 5120, P0, P1}; pg8::gemm_phase(lds, g, S, E); } }
      LSYNC(); }
    RP(15) { if (PH(15)) { ln_phase<true>(a, a.in[10] + D, a.in[11] + D, a.out, ada, vbln); } }
}

extern "C" void kernel_launch(void* const* d_in, const int* in_sizes, int n_in, void* d_out, int out_size, void* d_ws, size_t ws_size, hipStream_t stream) {
    static int grid = 0;
    if (grid == 0) {
        if (n_in != 29 || ws_size < WS_END) { fprintf(stderr, "kernel_launch: unexpected n_in %d or ws_size %zu (need %zu)\n", n_in, ws_size, (size_t)WS_END); grid = -1; return; }
        int dev = 0, cus = 0, per_cu = 0;
        hipGetDevice(&dev);
        hipDeviceGetAttribute(&cus, hipDeviceAttributeMultiprocessorCount, dev);
        if (hipFuncSetAttribute((const void*)fwd_megakernel, hipFuncAttributeMaxDynamicSharedMemorySize, LDS_BYTES) != hipSuccess) { fprintf(stderr, "kernel_launch: hipFuncSetAttribute failed\n"); grid = -1; return; }
        if (hipOccupancyMaxActiveBlocksPerMultiprocessor(&per_cu, (const void*)fwd_megakernel, NTHR, LDS_BYTES) != hipSuccess || per_cu < 1) { fprintf(stderr, "kernel_launch: occupancy query says %d\n", per_cu); per_cu = 1; }
        (void)hipGetLastError();
        grid = cus;
        if (grid > 256) grid = 256;
    }
    if (grid < 0) return;
    if (hipMemsetAsync((char*)d_ws + WS_BAR, 0, XB_ALL_WORDS * 4, stream) != hipSuccess) { fprintf(stderr, "kernel_launch: memset failed\n"); return; }
    Args a{};
    for (int i = 0; i < 29; ++i) a.in[i] = (const float*)d_in[i];
    a.out = (float*)d_out; a.ws = (unsigned char*)d_ws;
    void* args[] = {&a};
    hipError_t e = hipLaunchCooperativeKernel((const void*)fwd_megakernel, dim3(grid), dim3(NTHR), args, LDS_BYTES, stream);
    if (e != hipSuccess) fprintf(stderr, "cooperative launch failed: %s (grid %d)\n", hipGetErrorString(e), grid);
}
```

```cpp
#include <hip/hip_runtime.h>
#include <hip/hip_cooperative_groups.h>
#include <cstdio>
#include <cstdint>
namespace cg = cooperative_groups;

#define LAS __attribute__((address_space(3)))
typedef unsigned short bf16_t;
typedef short bf16x8 __attribute__((ext_vector_type(8)));
typedef float f32x4 __attribute__((ext_vector_type(4)));
typedef float f32x16 __attribute__((ext_vector_type(16)));
typedef unsigned u32x4 __attribute__((ext_vector_type(4)));
typedef unsigned u32x2 __attribute__((ext_vector_type(2)));

#ifndef HYREP
#define HYREP 0x0u
#endif
#ifndef P0REP
#define P0REP 0x0u
#endif
constexpr int D = 1024, NTOK = 8192, NPTOK = 4096, LP = 256, LSQ = 1024, DFF = 2816, NH = 16, HD = 64;
constexpr float ALPHA_C = 1.4142135623730951f;
constexpr float LN_EPS_C = 1e-5f;
constexpr int NWAVES = 8, NTHR = 512;
constexpr int LDS_BYTES = 147456;
constexpr int HY_WSTR = 17408;
constexpr int LDS_CTL = 8 * HY_WSTR;
constexpr int HY_ZERO = LDS_CTL + 64;

constexpr size_t MB = 1024 * 1024;
constexpr size_t WS_ADA    = 0;
constexpr size_t WS_BAR    = 245760;
constexpr size_t WS_WHYIN  = 256 * 1024;
constexpr size_t WS_WHYOUT = WS_WHYIN + 6 * MB;
constexpr size_t WS_WQKV   = WS_WHYOUT + 2 * MB;
constexpr size_t WS_WNAOUT = WS_WQKV + 6 * MB;
constexpr size_t WS_WFFIN  = WS_WNAOUT + 2 * MB;
constexpr size_t WS_WFFOUT = WS_WFFIN + 22 * MB;
constexpr size_t WS_RF256  = WS_WFFOUT + 11 * MB;
constexpr size_t WS_RF1024 = WS_RF256 + 1 * MB;
constexpr size_t WS_CK     = WS_RF1024 + 4 * MB;
constexpr size_t WS_CVT    = WS_CK + 2 * MB;
constexpr size_t WS_H      = WS_CVT + 4 * MB;
constexpr size_t WS_Y      = WS_H + 16 * MB;
constexpr size_t WS_X      = WS_Y + 16 * MB;
constexpr size_t WS_P0     = WS_X + 32 * MB;
constexpr size_t WS_P1     = WS_P0 + 32 * MB;
constexpr size_t WS_BIG    = WS_P1 + 32 * MB;
constexpr size_t WS_END    = WS_BIG + 64 * MB;
constexpr int VPP = 384, VPS = 1152, CVP = 384;
constexpr size_t BQ_OFF = 0, BK_OFF = (size_t)NTOK * D, BV_OFF = 2 * (size_t)NTOK * D, BVS_OFF = BV_OFF + (size_t)16 * NH * HD * VPP;

__device__ __forceinline__ int opaque_tid() { int t = threadIdx.x; asm volatile("" : "+v"(t)); return t; }
typedef float f32x2 __attribute__((ext_vector_type(2)));
typedef __bf16 bf16x2v __attribute__((ext_vector_type(2)));
__device__ __forceinline__ unsigned cvt_pk_bf16(float lo, float hi) { const f32x2 v = {lo, hi}; const bf16x2v b = __builtin_convertvector(v, bf16x2v); return __builtin_bit_cast(unsigned, b); }
__device__ __forceinline__ bf16_t f2bf(float x) { return (bf16_t)(cvt_pk_bf16(x, 0.f) & 0xffffu); }
__device__ __forceinline__ float bf2f(bf16_t b) { return __uint_as_float(((unsigned)b) << 16); }
__device__ __forceinline__ float bflo(unsigned w) { return __uint_as_float(w << 16); }
__device__ __forceinline__ float bfhi(unsigned w) { return __uint_as_float(w & 0xffff0000u); }
__device__ __forceinline__ float silu_f(float x) { return x * __builtin_amdgcn_rcpf(1.0f + __builtin_amdgcn_exp2f(-1.4426950408889634f * x)); }
__device__ __forceinline__ float wave_sum(float v) {
#pragma unroll
    for (int o = 1; o < 64; o <<= 1) v += __shfl_xor(v, o);
    return v;
}

namespace pg8 {
constexpr int BM = 256, BK = 64, HALF = 128, HTB = HALF * BK * 2, STAGE_BYTES = 8 * HTB, NXCD = 8, WGM = 4;
__device__ __forceinline__ int lds_byte(int r, int c) { const int st = (r >> 4) * 2 + (c >> 5), rr = r & 15, cc = c & 31, ob = rr * 64 + cc * 2; return st * 1024 + (ob ^ (((ob >> 9) & 1) << 5)); }
__device__ __forceinline__ void stage_rc(int b, int& R, int& C) { const int st = b / 1024, sb = b % 1024, swz = sb ^ (((sb >> 9) & 1) << 5); R = (st >> 1) * 16 + swz / 64; C = (st & 1) * 32 + (swz % 64) / 2; }
__device__ __forceinline__ int perm32(int rho) { const int n = rho >> 4, i = rho & 15; return 8 * (i >> 2) + 4 * n + (i & 3); }

struct Unit { int pm, pn, kh; };
struct Gemm { const bf16_t* A; const bf16_t* Bt; int K; int ld; };

struct Order {
    int nM, nN, nmn, ntot, G, c;
    __device__ void init(int M, int N, int ks, int G_, int c_) { nM = M / BM; nN = N / BM; nmn = nM * nN; ntot = nmn * ks; G = G_; c = c_; }
    __device__ bool next(int i, Unit& u) const {
        const int L = i * G + c; if (L >= ntot) return false;
        u.kh = L / nmn; int wgid = L - u.kh * nmn;
        { const int q = nmn / NXCD, r = nmn % NXCD, xcd = wgid % NXCD, off = wgid / NXCD; wgid = (xcd < r ? xcd * (q + 1) : r * (q + 1) + (xcd - r) * q) + off; }
        const int nig = WGM * nN, gid = wgid / nig, fm = gid * WGM, gsz = (nM - fm) < WGM ? (nM - fm) : WGM;
        u.pm = fm + ((wgid % nig) % gsz); u.pn = (wgid % nig) / gsz; return true;
    }
};

template <class Epi>
__device__ __forceinline__ void gemm_phase(LAS unsigned char* lds, const Gemm g, const Order& S, const Epi& E) {
    const int tid = opaque_tid(), wid = __builtin_amdgcn_readfirstlane(tid >> 6), lane = tid & 63, wr = wid >> 2, wc = wid & 3, fr = lane & 15, fq = lane >> 4;
    const int K = g.ld, nt = g.K / BK;
    unsigned voffA[2], voffB[2];
#pragma unroll
    for (int i = 0; i < 2; ++i) { int R, C; stage_rc(tid * 16 + i * 8192, R, C); const int Rb = Epi::PERM ? ((R & ~31) + perm32(R & 31)) : R;
        voffA[i] = (unsigned)(R * K + C) * 2u; voffB[i] = (unsigned)(Rb * K + C) * 2u; }
    const size_t kstep = (size_t)(BK * 2);
    const size_t hstep = (size_t)HALF * K * 2;
    const size_t tstep = 2 * hstep;
    const size_t khstep = (size_t)g.K * 2;
    const unsigned ldsw = (unsigned)wid * 1024u;
    const int aoff = lds_byte(wr * 64 + fr, fq * 8), boff = lds_byte(wc * 32 + fr, fq * 8);
#define PG8_SA(b, h) (((b) * 2 + (h)) * HTB)
#define PG8_SB(b, h) ((4 + (b) * 2 + (h)) * HTB)
#define PG8_STAGE(bufoff, gbase, voff) do { _Pragma("unroll") for (int _i = 0; _i < 2; ++_i) \
        __builtin_amdgcn_global_load_lds((const unsigned*)((const char*)(gbase) + (voff)[_i]), (LAS unsigned*)(lds + (bufoff) + ldsw + _i * 8192), 16, 0, 0); } while (0)
#define PG8_LDA(dst, b, h) do { _Pragma("unroll") for (int m = 0; m < 4; ++m) _Pragma("unroll") for (int k = 0; k < 2; ++k) dst[m][k] = *(const LAS bf16x8*)(lds + PG8_SA(b, h) + aoff + m * 2048 + k * 1024); } while (0)
#define PG8_LDB(dst, b, h) do { _Pragma("unroll") for (int n = 0; n < 2; ++n) _Pragma("unroll") for (int k = 0; k < 2; ++k) dst[n][k] = *(const LAS bf16x8*)(lds + PG8_SB(b, h) + boff + n * 2048 + k * 1024); } while (0)
#define PG8_MMA(ai, bj, At, Bt) do { __builtin_amdgcn_s_setprio(1); _Pragma("unroll") for (int m = 0; m < 4; ++m) _Pragma("unroll") for (int n = 0; n < 2; ++n) _Pragma("unroll") for (int k = 0; k < 2; ++k) \
        acc[ai][bj][m][n] = __builtin_amdgcn_mfma_f32_16x16x32_bf16(Bt[n][k], At[m][k], acc[ai][bj][m][n], 0, 0, 0); __builtin_amdgcn_s_setprio(0); } while (0)
#define PG8_WAIT_V(n) asm volatile("s_waitcnt vmcnt(" #n ")" ::: "memory")
#define PG8_WAIT_L(n) asm volatile("s_waitcnt lgkmcnt(" #n ")" ::: "memory")
#define PG8_BAR __builtin_amdgcn_s_barrier()
#define PG8_SCHED __builtin_amdgcn_sched_barrier(0)
    Unit cur, nxt; int ui = 0;
    if (!S.next(0, cur)) return;
    f32x4 acc[2][2][4][2];
#pragma unroll
    for (int a = 0; a < 2; ++a)
#pragma unroll
        for (int b = 0; b < 2; ++b)
#pragma unroll
            for (int m = 0; m < 4; ++m)
#pragma unroll
                for (int n = 0; n < 2; ++n) acc[a][b][m][n] = (f32x4){0.f, 0.f, 0.f, 0.f};
    bf16x8 At[4][2], B0[2][2], B1[2][2];
    const char* cA = (const char*)g.A + (size_t)cur.pm * tstep + (size_t)cur.kh * khstep; const char* cB = (const char*)g.Bt + (size_t)cur.pn * tstep + (size_t)cur.kh * khstep;
    PG8_STAGE(PG8_SB(0, 0), cB, voffB); PG8_STAGE(PG8_SB(0, 1), cB + hstep, voffB); PG8_STAGE(PG8_SA(0, 0), cA, voffA); PG8_STAGE(PG8_SA(0, 1), cA + hstep, voffA);
    if (wr == 1) PG8_BAR;
    PG8_WAIT_V(2); PG8_BAR;
    PG8_STAGE(PG8_SB(1, 0), cB + kstep, voffB); PG8_STAGE(PG8_SA(1, 0), cA + kstep, voffA); PG8_STAGE(PG8_SB(1, 1), cB + hstep + kstep, voffB);
    PG8_WAIT_V(6); PG8_BAR;
    for (;;) {
        const bool has_next = S.next(ui + 1, nxt);
        const char* nA = has_next ? (const char*)g.A + (size_t)nxt.pm * tstep + (size_t)nxt.kh * khstep : cA; const char* nB = has_next ? (const char*)g.Bt + (size_t)nxt.pn * tstep + (size_t)nxt.kh * khstep : cB;
        for (int t = 0; t < nt; t += 2) {
            const bool last = (t == nt - 2);
            const char* a1 = cA + (size_t)(t + 1) * kstep;
            const char* a2 = last ? nA : cA + (size_t)(t + 2) * kstep; const char* b2 = last ? nB : cB + (size_t)(t + 2) * kstep;
            const char* a3 = a2 + kstep; const char* b3 = b2 + kstep;
            PG8_LDB(B0, 0, 0); PG8_LDB(B1, 0, 1); PG8_SCHED; PG8_LDA(At, 0, 0); PG8_STAGE(PG8_SA(1, 1), a1 + hstep, voffA);
            PG8_WAIT_V(8); PG8_WAIT_L(0); PG8_BAR; PG8_MMA(0, 0, At, B0); PG8_MMA(0, 1, At, B1); PG8_BAR; PG8_SCHED;
            PG8_LDA(At, 0, 1); PG8_STAGE(PG8_SB(0, 0), b2, voffB); PG8_STAGE(PG8_SB(0, 1), b2 + hstep, voffB); PG8_STAGE(PG8_SA(0, 0), a2, voffA);
            PG8_WAIT_V(8); PG8_WAIT_L(0); PG8_BAR; PG8_MMA(1, 0, At, B0); PG8_MMA(1, 1, At, B1); PG8_BAR; PG8_SCHED;
            PG8_LDB(B0, 1, 0); PG8_LDB(B1, 1, 1); PG8_SCHED; PG8_LDA(At, 1, 0); PG8_STAGE(PG8_SA(0, 1), a2 + hstep, voffA);
            PG8_WAIT_V(8); PG8_WAIT_L(0); PG8_BAR; PG8_MMA(0, 0, At, B0); PG8_MMA(0, 1, At, B1); PG8_BAR; PG8_SCHED;
            PG8_LDA(At, 1, 1); PG8_STAGE(PG8_SB(1, 0), b3, voffB); PG8_STAGE(PG8_SB(1, 1), b3 + hstep, voffB); PG8_STAGE(PG8_SA(1, 0), a3, voffA);
            PG8_WAIT_V(8); PG8_WAIT_L(0); PG8_BAR; PG8_MMA(1, 0, At, B0); PG8_MMA(1, 1, At, B1); PG8_BAR; PG8_SCHED;
        }
        if (wr == 0) PG8_BAR;
        E(acc, cur, wr, wc, fr, fq);
        if (!has_next) break;
#pragma unroll
        for (int a = 0; a < 2; ++a)
#pragma unroll
            for (int b = 0; b < 2; ++b)
#pragma unroll
                for (int m = 0; m < 4; ++m)
#pragma unroll
                    for (int n = 0; n < 2; ++n) acc[a][b][m][n] = (f32x4){0.f, 0.f, 0.f, 0.f};
        cur = nxt; cA = nA; cB = nB; ++ui;
        if (wr == 1) PG8_BAR;
    }
    PG8_WAIT_V(0);
    PG8_BAR;
#undef PG8_SA
#undef PG8_SB
#undef PG8_STAGE
#undef PG8_LDA
#undef PG8_LDB
#undef PG8_MMA
#undef PG8_WAIT_V
#undef PG8_WAIT_L
#undef PG8_BAR
#undef PG8_SCHED
}

struct EpiBf16T {
    static constexpr bool PERM = true;
    bf16_t* O; int ldc;
    __device__ __forceinline__ void operator()(const f32x4 (&acc)[2][2][4][2], const Unit& u, int wr, int wc, int fr, int fq) const {
        const int row0 = u.pm * BM + wr * 64 + fr, col0 = u.pn * BM + wc * 32 + 8 * fq;
#pragma unroll
        for (int ai = 0; ai < 2; ++ai)
#pragma unroll
            for (int m = 0; m < 4; ++m) { bf16_t* rowp = O + (size_t)(row0 + ai * HALF + m * 16) * ldc + col0;
#pragma unroll
                for (int bj = 0; bj < 2; ++bj) { const f32x4 v0 = acc[ai][bj][m][0], v1 = acc[ai][bj][m][1];
                    u32x4 w; w.x = cvt_pk_bf16(v0[0], v0[1]); w.y = cvt_pk_bf16(v0[2], v0[3]); w.z = cvt_pk_bf16(v1[0], v1[1]); w.w = cvt_pk_bf16(v1[2], v1[3]);
                    *(u32x4*)(rowp + bj * HALF) = w; } }
    }
};
template <bool BASE_F32>
struct EpiRes {
    static constexpr bool PERM = true;
    const void* bp; const void* bs;
    const float* gate;
    bf16_t* P0; bf16_t* P1;
    __device__ __forceinline__ void operator()(const f32x4 (&acc)[2][2][4][2], const Unit& u, int wr, int wc, int fr, int fq) const {
        const int row0 = u.pm * BM + wr * 64 + fr, col0 = u.pn * BM + wc * 32 + 8 * fq;
        const int v = (u.pm < 16) ? 0 : 1 + ((u.pm - 16) >> 2);
        f32x4 gv[2][2];
#pragma unroll
        for (int bj = 0; bj < 2; ++bj)
#pragma unroll
            for (int n = 0; n < 2; ++n) gv[bj][n] = *(const f32x4*)(gate + v * 6144 + col0 + bj * HALF + 4 * n);
        bf16_t* P = u.kh ? P1 : P0;
#pragma unroll
        for (int ai = 0; ai < 2; ++ai)
#pragma unroll
            for (int m = 0; m < 4; ++m) { bf16_t* rowp = P + (size_t)(row0 + ai * HALF + m * 16) * D + col0;
#pragma unroll
                for (int bj = 0; bj < 2; ++bj) { const f32x4 y0 = gv[bj][0] * acc[ai][bj][m][0], y1 = gv[bj][1] * acc[ai][bj][m][1];
                    u32x4 w; w.x = cvt_pk_bf16(y0[0], y0[1]); w.y = cvt_pk_bf16(y0[2], y0[3]); w.z = cvt_pk_bf16(y1[0], y1[1]); w.w = cvt_pk_bf16(y1[2], y1[3]);
                    *(u32x4*)(rowp + bj * HALF) = w; } }
    }
};
struct EpiSwiglu {
    static constexpr bool PERM = true;
    bf16_t* O;
    __device__ __forceinline__ void operator()(const f32x4 (&acc)[2][2][4][2], const Unit& u, int wr, int wc, int fr, int fq) const {
        const int row0 = u.pm * BM + wr * 64 + fr;
#pragma unroll
        for (int ai = 0; ai < 2; ++ai)
#pragma unroll
            for (int m = 0; m < 4; ++m) { bf16_t* rowp = O + (size_t)(row0 + ai * HALF + m * 16) * DFF + u.pn * 128 + wc * 32 + 8 * fq;
                const f32x4 a0 = acc[ai][0][m][0], a1 = acc[ai][0][m][1], b0 = acc[ai][1][m][0], b1 = acc[ai][1][m][1];
                u32x4 w; w.x = cvt_pk_bf16(silu_f(a0[0]) * b0[0], silu_f(a0[1]) * b0[1]); w.y = cvt_pk_bf16(silu_f(a0[2]) * b0[2], silu_f(a0[3]) * b0[3]);
                w.z = cvt_pk_bf16(silu_f(a1[0]) * b1[0], silu_f(a1[1]) * b1[1]); w.w = cvt_pk_bf16(silu_f(a1[2]) * b1[2], silu_f(a1[3]) * b1[3]);
                *(u32x4*)rowp = w; }
    }
};
struct EpiQKV {
    static constexpr bool PERM = true;
    bf16_t* B; float* newk; float* newv;
    __device__ __forceinline__ void operator()(const f32x4 (&acc)[2][2][4][2], const Unit& u, int wr, int wc, int fr, int fq) const {
        const int row0 = u.pm * BM + wr * 64 + fr, col0 = u.pn * BM + wc * 32 + 8 * fq;
        const bool prompt = u.pm < 16;
        if (u.pn < 4) {
#pragma unroll
            for (int ai = 0; ai < 2; ++ai)
#pragma unroll
                for (int m = 0; m < 4; ++m) { const int row = row0 + ai * HALF + m * 16; bf16_t* rowp = B + BQ_OFF + (size_t)row * D + col0;
#pragma unroll
                    for (int bj = 0; bj < 2; ++bj) { const f32x4 x0 = acc[ai][bj][m][0] * 0.125f, x1 = acc[ai][bj][m][1] * 0.125f;
                        u32x4 w; w.x = cvt_pk_bf16(x0[0], x0[1]); w.y = cvt_pk_bf16(x0[2], x0[3]); w.z = cvt_pk_bf16(x1[0], x1[1]); w.w = cvt_pk_bf16(x1[2], x1[3]);
                        *(u32x4*)(rowp + bj * HALF) = w; } }
        } else if (u.pn < 8) {
#pragma unroll
            for (int ai = 0; ai < 2; ++ai)
#pragma unroll
                for (int m = 0; m < 4; ++m) { const int row = row0 + ai * HALF + m * 16;
                    int b, s, L; size_t kb;
                    if (prompt) { b = row >> 8; s = row & 255; L = LP; kb = BK_OFF; } else { b = (row - NPTOK) >> 10; s = (row - NPTOK) & 1023; L = LSQ; kb = BK_OFF + (size_t)NPTOK * D; }
#pragma unroll
                    for (int bj = 0; bj < 2; ++bj) { const int c = col0 + bj * HALF - 1024, hh = c >> 6, dd = c & 63; const f32x4 x0 = acc[ai][bj][m][0], x1 = acc[ai][bj][m][1];
                        u32x4 w; w.x = cvt_pk_bf16(x0[0], x0[1]); w.y = cvt_pk_bf16(x0[2], x0[3]); w.z = cvt_pk_bf16(x1[0], x1[1]); w.w = cvt_pk_bf16(x1[2], x1[3]);
                        *(u32x4*)(B + kb + ((size_t)((b * NH + hh) * L + s)) * HD + dd) = w;
                        if (prompt) { float* nk = newk + ((size_t)((b * NH + hh) * LP + s)) * HD + dd; *(f32x4*)nk = x0; *(f32x4*)(nk + 4) = x1; } } }
        } else {
            const bool odd = (fr & 1) != 0;
#pragma unroll
            for (int ai = 0; ai < 2; ++ai)
#pragma unroll
                for (int m = 0; m < 4; ++m) { const int row = row0 + ai * HALF + m * 16;
                    int b, s, P; size_t vb;
                    if (prompt) { b = row >> 8; s = row & 255; P = VPP; vb = BV_OFF; } else { b = (row - NPTOK) >> 10; s = (row - NPTOK) & 1023; P = VPS; vb = BVS_OFF; }
#pragma unroll
                    for (int bj = 0; bj < 2; ++bj)
#pragma unroll
                        for (int n = 0; n < 2; ++n) { const int c = col0 + bj * HALF + 4 * n - 2048, hh = c >> 6, dd = c & 63; const f32x4 x = acc[ai][bj][m][n];
                            f32x4 y;
#pragma unroll
                            for (int e = 0; e < 4; ++e) y[e] = __shfl_xor(x[e], 1);
                            const unsigned w0 = odd ? cvt_pk_bf16(y[1], x[1]) : cvt_pk_bf16(x[0], y[0]);
                            const unsigned w1 = odd ? cvt_pk_bf16(y[3], x[3]) : cvt_pk_bf16(x[2], y[2]);
                            bf16_t* vq = B + vb + ((size_t)((b * NH + hh) * HD + dd + (odd ? 1 : 0))) * P + (s & ~1);
                            *(unsigned*)vq = w0; *(unsigned*)(vq + 2 * P) = w1;
                            if (prompt) *(f32x4*)(newv + ((size_t)((b * NH + hh) * LP + s)) * HD + dd) = x; } }
        }
    }
};
}


#define XB_TMO      128
#define XB_XCNT(j)  (256  + 64 * (j))
#define XB_XSUB(j)  (1280 + 64 * (j))
#define XB_XGEN(j)  (2304 + 64 * (j))
#define XB_TOP      3328
#define XB_TOPGEN   3392
#define XCD_BAR_WORDS 3456
#define XB_LSUB(j)  (3456 + 16 * (j))
#define XB_LGEN(j)  (3712 + 16 * (j))
#define XB_ALL_WORDS 4096
#define XB_SPIN_CAP (1u << 18)
__device__ __forceinline__ unsigned xb_ld(unsigned* p)              { return __hip_atomic_load(p, __ATOMIC_RELAXED, __HIP_MEMORY_SCOPE_AGENT); }
__device__ __forceinline__ unsigned xb_add(unsigned* p, unsigned v) { return __hip_atomic_fetch_add(p, v, __ATOMIC_RELAXED, __HIP_MEMORY_SCOPE_AGENT); }
__device__ __forceinline__ unsigned xb_xcc_id() { return (unsigned)__builtin_amdgcn_s_getreg((3 << 11) | 20) & 0xFu; }
#define XB_SPIN(cond, bar) do { unsigned _sp = 0; while (cond) { __builtin_amdgcn_s_sleep(1); \
    if ((++_sp & 255u) == 0u) { if (xb_ld(&(bar)[XB_TMO])) break; if (_sp > XB_SPIN_CAP) { atomicAdd(&(bar)[XB_TMO], 1u); break; } } } } while (0)
struct XcdBarrier { unsigned* bar; unsigned x; volatile LAS unsigned* st; };
__device__ __forceinline__ XcdBarrier xcd_barrier_post(unsigned* bar, volatile LAS unsigned* st) {
    XcdBarrier b; b.bar = bar; b.x = xb_xcc_id(); b.st = st;
    if (opaque_tid() == 0) st[3] = xb_add(&bar[XB_XCNT(b.x)], 1u);
    return b;
}
__device__ __forceinline__ void xcd_barrier_complete(unsigned* bar, unsigned x, unsigned& nloc, unsigned& nx) {
    const unsigned G = gridDim.x * gridDim.y * gridDim.z;
    unsigned sum, cnt, mine, sp = 0u;
    for (;;) {
        sum = 0u; cnt = 0u; mine = 0u;
#pragma unroll
        for (unsigned j = 0; j < 16; ++j) { const unsigned c = xb_ld(&bar[XB_XCNT(j)]); sum += c; cnt += (c > 0u) ? 1u : 0u; mine = (j == x) ? c : mine; }
        if (sum == G) break;
        __builtin_amdgcn_s_sleep(1);
        if ((++sp & 255u) == 0u) { if (xb_ld(&bar[XB_TMO])) break; if (sp > XB_SPIN_CAP) { atomicAdd(&bar[XB_TMO], 1u); break; } }
    }
    nloc = mine > 0u ? mine : 1u; nx = cnt > 0u ? cnt : 1u;
}
__device__ __forceinline__ unsigned xcd_census_uniform(unsigned* bar) {
    unsigned ok = (gridDim.x == 256u) ? 1u : 0u;
#pragma unroll
    for (unsigned j = 0; j < 16; ++j) { const unsigned c = xb_ld(&bar[XB_XCNT(j)]); if (c != (j < 8u ? 32u : 0u)) ok = 0u; }
    return ok;
}
__device__ __forceinline__ void xcd_barrier(const XcdBarrier& b) {
    asm volatile("s_waitcnt vmcnt(0)" ::: "memory");
    __syncthreads();
    if (opaque_tid() == 0) {
        unsigned* bar = b.bar;
        __builtin_amdgcn_s_waitcnt(0);
        unsigned nloc = b.st[0], nx = b.st[1];
        if (nloc == 0u) { xcd_barrier_complete(bar, b.x, nloc, nx); b.st[0] = nloc; b.st[1] = nx; b.st[2] = xcd_census_uniform(bar); }
        const unsigned old = xb_add(&bar[XB_XSUB(b.x)], 1u);
        const unsigned gen = old / nloc;
        if (old + 1u == (gen + 1u) * nloc) {
            __builtin_amdgcn_fence(__ATOMIC_RELEASE, "agent");
            asm volatile("s_waitcnt vmcnt(0)" ::: "memory");
            const unsigned og = xb_add(&bar[XB_TOP], 1u);
            const unsigned tg = og / nx;
            if (og + 1u == (tg + 1u) * nx) xb_add(&bar[XB_TOPGEN], 1u);
            else XB_SPIN(xb_ld(&bar[XB_TOPGEN]) == tg, bar);
            __builtin_amdgcn_fence(__ATOMIC_ACQUIRE, "agent");
            xb_add(&bar[XB_XGEN(b.x)], 1u);
            asm volatile("s_waitcnt vmcnt(0)" ::: "memory");
        } else {
            XB_SPIN(xb_ld(&bar[XB_XGEN(b.x)]) == gen, bar);
            __builtin_amdgcn_fence(__ATOMIC_ACQUIRE, "agent");
            asm volatile("s_waitcnt vmcnt(0)" ::: "memory");
        }
    }
    __syncthreads();
}
__device__ __forceinline__ void xcd_local_barrier(const XcdBarrier& b) {
    asm volatile("s_waitcnt vmcnt(0)" ::: "memory");
    __syncthreads();
    if (opaque_tid() == 0) {
        unsigned* bar = b.bar;
        __builtin_amdgcn_s_waitcnt(0);
        const unsigned nloc = b.st[0];
        const unsigned old = xb_add(&bar[XB_LSUB(b.x)], 1u);
        const unsigned gen = old / nloc;
        if (old + 1u == (gen + 1u) * nloc) xb_add(&bar[XB_LGEN(b.x)], 1u);
        else XB_SPIN(xb_ld(&bar[XB_LGEN(b.x)]) == gen, bar);
        __builtin_amdgcn_fence(__ATOMIC_ACQUIRE, "agent");
        asm volatile("s_waitcnt vmcnt(0)" ::: "memory");
    }
    __syncthreads();
}

struct Args { const float* in[29]; float* out; unsigned char* ws; };

__device__ __forceinline__ void transpose_item(const float* __restrict__ W, int K, int N, bf16_t* WT, int mode, LAS float* scr, int item, int lane) {
    const int nblk = N / 32, kb = item / nblk, nb = item % nblk, k0 = 64 * kb, r0 = 32 * nb;
    const int T_ = r0 >> 8, w_ = r0 & 255;
    const int srcbase = (mode == 0) ? r0 : ((w_ < 128) ? (128 * T_ + w_) : (DFF + 128 * T_ + w_ - 128));
    const int c4 = lane & 7, rsub = lane >> 3;
    const float* p = W + (size_t)(k0 + rsub) * N + srcbase + 4 * c4;
    f32x4 tv[8];
#pragma unroll
    for (int i = 0; i < 8; ++i) tv[i] = *(const f32x4*)(p + (size_t)(8 * i) * N);
#pragma unroll
    for (int i = 0; i < 8; ++i) { LAS float* d = scr + (8 * i + rsub) * 33 + 4 * c4; d[0] = tv[i][0]; d[1] = tv[i][1]; d[2] = tv[i][2]; d[3] = tv[i][3]; }
    asm volatile("s_waitcnt lgkmcnt(0)" ::: "memory");
    const int c = lane & 7;
#pragma unroll
    for (int j = 0; j < 4; ++j) { const int n = (lane >> 3) + 8 * j; const LAS float* s = scr + (8 * c) * 33 + n;
        u32x4 o; o.x = cvt_pk_bf16(s[0 * 33], s[1 * 33]); o.y = cvt_pk_bf16(s[2 * 33], s[3 * 33]); o.z = cvt_pk_bf16(s[4 * 33], s[5 * 33]); o.w = cvt_pk_bf16(s[6 * 33], s[7 * 33]);
        *(u32x4*)(WT + (size_t)(r0 + n) * K + k0 + 8 * c) = o; }
    asm volatile("s_waitcnt lgkmcnt(0)" ::: "memory");
}

constexpr int TI0 = 1536, TI1 = 512, TI2 = 1536, TI3 = 512, TI4 = 2816, TI6 = 1408;
constexpr int TR_P0_END = TI0 + TI1;
constexpr int TR_S2_BEG = TR_P0_END, TR_S2_END = TR_S2_BEG + TI2 + TI3;
constexpr int TR_S1_BEG = TR_S2_END, TR_S1_END = TR_S1_BEG + TI4 + TI6;
constexpr int TR_S3_BEG = TR_S1_END, TR_S3_END = TR_S3_BEG + TI4 + TI6;
__device__ __forceinline__ void transpose_dispatch(const Args& a, LAS float* scr, int r, int lane) {
    if (r < TI0) { transpose_item(a.in[14], 1024, 3072, (bf16_t*)(a.ws + WS_WHYIN), 0, scr, r, lane); return; } r -= TI0;
    if (r < TI1) { transpose_item(a.in[25], 1024, 1024, (bf16_t*)(a.ws + WS_WHYOUT), 0, scr, r, lane); return; } r -= TI1;
    if (r < TI2) { transpose_item(a.in[26], 1024, 3072, (bf16_t*)(a.ws + WS_WQKV), 0, scr, r, lane); return; } r -= TI2;
    if (r < TI3) { transpose_item(a.in[28], 1024, 1024, (bf16_t*)(a.ws + WS_WNAOUT), 0, scr, r, lane); return; } r -= TI3;
    if (r < TI4) { transpose_item(a.in[12], 1024, 5632, (bf16_t*)(a.ws + WS_WFFIN), 1, scr, r, lane); return; } r -= TI4;
    if (r < TI6) { transpose_item(a.in[13], DFF, 1024, (bf16_t*)(a.ws + WS_WFFOUT), 0, scr, r, lane); return; } r -= TI6;
    if (r < TI4) { transpose_item(a.in[12] + (size_t)1024 * 5632, 1024, 5632, (bf16_t*)(a.ws + WS_WFFIN) + (size_t)5632 * 1024, 1, scr, r, lane); return; } r -= TI4;
    transpose_item(a.in[13] + (size_t)DFF * 1024, DFF, 1024, (bf16_t*)(a.ws + WS_WFFOUT) + (size_t)1024 * DFF, 0, scr, r, lane);
}
__device__ __forceinline__ void deferred_transposes(const Args& a, LAS unsigned char* lds, int r0, int r1, int slot, int nslots) {
    const int lane = opaque_tid() & 63, wave = opaque_tid() >> 6;
    LAS float* scr = (LAS float*)(lds + wave * 16384);
    for (int r = r0 + slot * 8 + wave; r < r1; r += nslots * 8) transpose_dispatch(a, scr, r, lane);
    __syncthreads();
}

__device__ __forceinline__ void ada_item(const Args& a, LAS unsigned char* lds, int it) {
    const int tid = opaque_tid();
    const int layer = it / 96, n0 = 64 * (it % 96);
    LAS float* sl = (LAS float*)lds;
    LAS float* part = (LAS float*)(lds + 20480);
    const float* cs = a.in[4]; const float* cctx = a.in[5];
    for (int i = tid; i < 5 * 1024; i += NTHR) { const int v = i >> 10, k = i & 1023; const float x = (v == 0) ? cctx[k] : cs[(v - 1) * 1024 + k]; sl[i] = x / (1.0f + expf(-x)); }
    __syncthreads();
    const int ln = tid & 15, kg = tid >> 4;
    const float* w = a.in[6] + ((size_t)layer * 1024 + kg * 32) * 6144 + n0 + 4 * ln;
    f32x4 acc[5];
#pragma unroll
    for (int v = 0; v < 5; ++v) acc[v] = (f32x4){0.f, 0.f, 0.f, 0.f};
#pragma unroll 16
    for (int kk = 0; kk < 32; ++kk) { const f32x4 wv = *(const f32x4*)(w + (size_t)kk * 6144); const int k = kg * 32 + kk;
#pragma unroll
        for (int v = 0; v < 5; ++v) acc[v] += wv * sl[v * 1024 + k]; }
#pragma unroll
    for (int v = 0; v < 5; ++v) *(LAS f32x4*)(part + (kg * 5 + v) * 64 + 4 * ln) = acc[v];
    __syncthreads();
    if (tid < 320) { const int v = tid >> 6, n = tid & 63; float s = a.in[7][layer * 6144 + n0 + n];
        for (int g = 0; g < 32; ++g) s += part[(g * 5 + v) * 64 + n];
        __hip_atomic_store((float*)(a.ws + WS_ADA) + (layer * 5 + v) * 6144 + n0 + n, s, __ATOMIC_RELAXED, __HIP_MEMORY_SCOPE_AGENT); }
    asm volatile("s_waitcnt vmcnt(0)" ::: "memory");
    __syncthreads();
    if (tid == 0 && it < 32) (void)__hip_atomic_fetch_add((unsigned*)(a.ws + WS_BAR) + 1, 1u, __ATOMIC_RELAXED, __HIP_MEMORY_SCOPE_AGENT);
}

__device__ __forceinline__ void filter_item(const Args& a, LAS unsigned char* lds, int it) {
    const int tid = opaque_tid(), lane = tid & 63, wave = tid >> 6;
    int L, pg; bf16_t* R;
    if (it < 32) { L = 256; pg = it; R = (bf16_t*)(a.ws + WS_RF256); } else { L = 1024; pg = it - 32; R = (bf16_t*)(a.ws + WS_RF1024); }
    LAS float* H2 = (LAS float*)lds;
    LAS float* fs = (LAS float*)(lds + 4096) + wave * 128;
    const float* w1 = a.in[17]; const float* b1 = a.in[18]; const float* w2 = a.in[19]; const float* b2 = a.in[20]; const float* w3 = a.in[21];
    const float* fq = a.in[22]; const float* dec = a.in[23]; const float* hb = a.in[24];
    LAS float* w1s = (LAS float*)(lds + 8192);
    LAS float* w2s = (LAS float*)(lds + 8192 + 8448);
    { float t1[5], t2[8];
#pragma unroll
      for (int k = 0; k < 5; ++k) { const int i = tid + k * NTHR; t1[k] = (i < 33 * 64) ? w1[i] : 0.f; }
#pragma unroll
      for (int k = 0; k < 8; ++k) t2[k] = w2[tid + k * NTHR];
#pragma unroll
      for (int k = 0; k < 5; ++k) { const int i = tid + k * NTHR; if (i < 33 * 64) w1s[i] = t1[k]; }
#pragma unroll
      for (int k = 0; k < 8; ++k) w2s[tid + k * NTHR] = t2[k]; }
    __syncthreads();
    {
        const int pl = wave, pos = pg * 8 + pl;
        const float tn = (float)pos / (float)(L - 1);
        const float wang = (6.283185307179586f / (float)L) * (float)pos;
        if (lane < 33) { float f;
            if (lane == 0) f = tn;
            else { const int kb = (lane - 1) & 15; const float band = 1e-4f + (float)kb * ((15.0f - 1e-4f) / 15.0f); const float arg = band * wang; f = (lane <= 16) ? cosf(arg) : sinf(arg); }
            fs[lane] = f; }
        asm volatile("s_waitcnt lgkmcnt(0)" ::: "memory");
        float s = b1[lane];
#pragma unroll 11
        for (int e = 0; e < 33; ++e) s += fs[e] * w1s[e * 64 + lane];
        fs[64 + lane] = sinf(fq[lane] * s);
        asm volatile("s_waitcnt lgkmcnt(0)" ::: "memory");
        float s2 = b2[lane];
#pragma unroll 16
        for (int e = 0; e < 64; ++e) s2 += fs[64 + e] * w2s[e * 64 + lane];
        H2[pl * 64 + lane] = sinf(fq[64 + lane] * s2);
        asm volatile("s_waitcnt lgkmcnt(0)" ::: "memory");
    }
    __syncthreads();
    const f32x4 dc = *(const f32x4*)(dec + 4 * tid);
    {
        f32x4 acc[8];
#pragma unroll
        for (int p = 0; p < 8; ++p) acc[p] = (f32x4){0.f, 0.f, 0.f, 0.f};
#pragma unroll 16
        for (int e = 0; e < 64; ++e) { const f32x4 wv = *(const f32x4*)(w3 + (size_t)e * 2048 + 4 * tid);
#pragma unroll
            for (int p = 0; p < 8; ++p) acc[p] += wv * H2[p * 64 + e]; }
#pragma unroll
        for (int cc = 0; cc < 4; ++cc) { const int c = 4 * tid + cc; const float ad = fabsf(dc[cc]);
            float v8[8];
#pragma unroll
            for (int p = 0; p < 8; ++p) { const float tn = (float)(pg * 8 + p) / (float)(L - 1); v8[p] = acc[p][cc] * (__expf(-tn * ad) + 0.05f); }
            if (c < D) {
                if (pg == 0) v8[0] += hb[c];
                u32x4 w; w.x = cvt_pk_bf16(v8[7], v8[6]); w.y = cvt_pk_bf16(v8[5], v8[4]); w.z = cvt_pk_bf16(v8[3], v8[2]); w.w = cvt_pk_bf16(v8[1], v8[0]);
                *(u32x4*)(R + (size_t)c * 2 * L + L - 8 * (pg + 1)) = w;
            } else {
                bf16_t* row = R + (size_t)(c - D) * 2 * L; const int m0 = L - 1 + 8 * pg;
                if (pg == 0) row[2 * L - 1] = 0; else row[m0] = f2bf(v8[0]);
                *(unsigned*)(row + m0 + 1) = cvt_pk_bf16(v8[1], v8[2]); *(unsigned*)(row + m0 + 3) = cvt_pk_bf16(v8[3], v8[4]); *(unsigned*)(row + m0 + 5) = cvt_pk_bf16(v8[5], v8[6]);
                row[m0 + 7] = f2bf(v8[7]);
            }
        }
    }
    __syncthreads();
}

__device__ __forceinline__ void e1_item(const Args& a, int e) {
    const int tid = opaque_tid(), lane = tid & 63, wave = tid >> 6;
    if (tid == 0) { unsigned* done = (unsigned*)(a.ws + WS_BAR) + 1; unsigned sp = 0u;
        while (__hip_atomic_load(done, __ATOMIC_RELAXED, __HIP_MEMORY_SCOPE_AGENT) < 32u) { __builtin_amdgcn_s_sleep(2); if (++sp > (1u << 20)) break; }
        __builtin_amdgcn_fence(__ATOMIC_ACQUIRE, "agent");
        asm volatile("s_waitcnt vmcnt(0)" ::: "memory"); }
    __syncthreads();
    const float* ada = (const float*)(a.ws + WS_ADA);
    bf16_t* H = (bf16_t*)(a.ws + WS_H);
    const int rowb = 32 * e + 4 * wave;
    const float* av = ada + ((rowb < NPTOK) ? 0 : 1 + ((rowb - NPTOK) >> 10)) * 6144;
    f32x4 sh[2][2], sc[2][2];
#pragma unroll
    for (int j = 0; j < 2; ++j) { const int col = 8 * lane + 512 * j; sh[j][0] = *(const f32x4*)(av + col); sh[j][1] = *(const f32x4*)(av + col + 4); sc[j][0] = *(const f32x4*)(av + 1024 + col); sc[j][1] = *(const f32x4*)(av + 1028 + col); }
#pragma unroll
    for (int i = 0; i < 4; ++i) { const int row = rowb + i;
        const float* src = (row < NPTOK) ? a.in[0] + (size_t)row * D : a.in[1] + (size_t)(row - NPTOK) * D;
#pragma unroll
        for (int j = 0; j < 2; ++j) { const int col = 8 * lane + 512 * j;
            const f32x4 x0 = *(const f32x4*)(src + col), x1 = *(const f32x4*)(src + col + 4);
            const f32x4 y0 = x0 * (sc[j][0] + 1.0f) + sh[j][0], y1 = x1 * (sc[j][1] + 1.0f) + sh[j][1];
            u32x4 w; w.x = cvt_pk_bf16(y0[0], y0[1]); w.y = cvt_pk_bf16(y0[2], y0[3]); w.z = cvt_pk_bf16(y1[0], y1[1]); w.w = cvt_pk_bf16(y1[2], y1[3]);
            *(u32x4*)(H + (size_t)row * D + col) = w; } }
}

__device__ __forceinline__ void p0_prep(const Args& a, LAS unsigned char* lds) {
    const int tid = opaque_tid(), lane = tid & 63, wave = tid >> 6, bx = blockIdx.x, G = gridDim.x;
    LAS float* scr = (LAS float*)(lds + wave * 16384);
    constexpr int NIT = TR_P0_END, NCHUNK = NIT / 8, NE1 = NTOK / 32, NFILT = 160, NPRE = NFILT + 192, NITEMS = NPRE + NCHUNK + NE1;
    static_assert(NIT % 8 == 0, "transpose items in chunks of 8");
    unsigned* ctr = (unsigned*)(a.ws + WS_BAR);
    volatile LAS int* nxt = (volatile LAS int*)(lds + LDS_CTL + 128);
    for (;;) {
        __syncthreads();
        if (tid == 0) *nxt = (int)__hip_atomic_fetch_add(ctr, 1u, __ATOMIC_RELAXED, __HIP_MEMORY_SCOPE_AGENT);
        __syncthreads();
        const int item = *nxt;
        if (item >= NITEMS) break;
        if (item < NFILT) { filter_item(a, lds, item); continue; }
        if (item < NPRE) { ada_item(a, lds, item - NFILT); continue; }
        if (item >= NPRE + NCHUNK) { e1_item(a, item - NPRE - NCHUNK); continue; }
        transpose_dispatch(a, scr, (item - NPRE) * 8 + wave, lane);
    }
    __syncthreads();
}

__device__ __forceinline__ void e1_modulate(const Args& a) {
    const int lane = opaque_tid() & 63, gw = blockIdx.x * NWAVES + (opaque_tid() >> 6), NGW = gridDim.x * NWAVES;
    const float* ada = (const float*)(a.ws + WS_ADA);
    bf16_t* H = (bf16_t*)(a.ws + WS_H);
    for (int row = gw; row < NTOK; row += NGW) {
        const float* src = (row < NPTOK) ? a.in[0] + (size_t)row * D : a.in[1] + (size_t)(row - NPTOK) * D;
        const int v = (row < NPTOK) ? 0 : 1 + ((row - NPTOK) >> 10);
        const float* av = ada + v * 6144;
#pragma unroll
        for (int j = 0; j < 4; ++j) { const int col = 4 * lane + 256 * j;
            const f32x4 x = *(const f32x4*)(src + col), sh = *(const f32x4*)(av + col), sc = *(const f32x4*)(av + 1024 + col);
            const f32x4 y = x * (sc + 1.0f) + sh; u32x2 w; w.x = cvt_pk_bf16(y[0], y[1]); w.y = cvt_pk_bf16(y[2], y[3]);
            *(u32x2*)(H + (size_t)row * D + col) = w; }
    }
}
template <bool FINAL> __device__ __forceinline__ void ln_rows4(const Args& a, const float* lng, const float* lnb, float* xout, const float* adav, int rowbase, const float* bpf, const float* bsf);
template <bool FINAL>
__device__ __forceinline__ void ln_phase(const Args& a, const float* lng, const float* lnb, float* xout, const float* adav  , int vb = -1, const float* bpf = nullptr, const float* bsf = nullptr) {
    if (vb >= 0) { ln_rows4<FINAL>(a, lng, lnb, xout, adav, 1024 * (vb & 7) + 32 * (vb >> 3) + 4 * (opaque_tid() >> 6), bpf, bsf); return; }
    const int lane = opaque_tid() & 63, wv = opaque_tid() >> 6;
    const int gw = (vb >= 0) ? (1024 * (vb & 7) + 32 * (vb >> 3) + 4 * wv) : (int)(blockIdx.x * NWAVES + wv), NGW = (vb >= 0) ? 1 : (int)(gridDim.x * NWAVES);
    const int rend = (vb >= 0) ? gw + 4 : NTOK;
    const bf16_t* P0 = (const bf16_t*)(a.ws + WS_P0); const bf16_t* P1 = (const bf16_t*)(a.ws + WS_P1);
    bf16_t* H = (bf16_t*)(a.ws + WS_H); bf16_t* X = (bf16_t*)(a.ws + WS_X);
    for (int row = gw; row < rend; row += NGW) {
        float v[16]; float s = 0.f;
#pragma unroll
        for (int j = 0; j < 2; ++j) { const int col = 8 * lane + 512 * j;
            const u32x4 p = *(const u32x4*)(P0 + (size_t)row * D + col), q = *(const u32x4*)(P1 + (size_t)row * D + col);
            v[8 * j + 0] = bflo(p.x) + bflo(q.x); v[8 * j + 1] = bfhi(p.x) + bfhi(q.x); v[8 * j + 2] = bflo(p.y) + bflo(q.y); v[8 * j + 3] = bfhi(p.y) + bfhi(q.y);
            v[8 * j + 4] = bflo(p.z) + bflo(q.z); v[8 * j + 5] = bfhi(p.z) + bfhi(q.z); v[8 * j + 6] = bflo(p.w) + bflo(q.w); v[8 * j + 7] = bfhi(p.w) + bfhi(q.w);
            if (bpf) { const float* br = ((row < NPTOK) ? bpf + (size_t)row * D : bsf + (size_t)(row - NPTOK) * D) + col; const f32x4 b0 = *(const f32x4*)br, b1 = *(const f32x4*)(br + 4);
#pragma unroll
                for (int e = 0; e < 4; ++e) { v[8 * j + e] += ALPHA_C * b0[e]; v[8 * j + 4 + e] += ALPHA_C * b1[e]; } }
            else { const u32x4 xb = *(const u32x4*)((const bf16_t*)(a.ws + WS_X) + (size_t)row * D + col);
                v[8 * j + 0] += ALPHA_C * bflo(xb.x); v[8 * j + 1] += ALPHA_C * bfhi(xb.x); v[8 * j + 2] += ALPHA_C * bflo(xb.y); v[8 * j + 3] += ALPHA_C * bfhi(xb.y);
                v[8 * j + 4] += ALPHA_C * bflo(xb.z); v[8 * j + 5] += ALPHA_C * bfhi(xb.z); v[8 * j + 6] += ALPHA_C * bflo(xb.w); v[8 * j + 7] += ALPHA_C * bfhi(xb.w); } }
#pragma unroll
        for (int e = 0; e < 16; ++e) s += v[e];
        const float mean = wave_sum(s) * (1.0f / D); float s2 = 0.f;
#pragma unroll
        for (int e = 0; e < 16; ++e) { v[e] -= mean; s2 += v[e] * v[e]; }
        const float rstd = 1.0f / sqrtf(wave_sum(s2) * (1.0f / D) + LN_EPS_C);
        const int vi = (row < NPTOK) ? 0 : 1 + ((row - NPTOK) >> 10);
#pragma unroll
        for (int j = 0; j < 2; ++j) { const int col = 8 * lane + 512 * j;
            const f32x4 g0 = *(const f32x4*)(lng + col), g1 = *(const f32x4*)(lng + col + 4), b0 = *(const f32x4*)(lnb + col), b1 = *(const f32x4*)(lnb + col + 4);
            f32x4 y0, y1;
#pragma unroll
            for (int e = 0; e < 4; ++e) { y0[e] = v[8 * j + e] * rstd * g0[e] + b0[e]; y1[e] = v[8 * j + 4 + e] * rstd * g1[e] + b1[e]; }
            if (FINAL) { *(f32x4*)(xout + (size_t)row * D + col) = y0; *(f32x4*)(xout + (size_t)row * D + col + 4) = y1; }
            else {
                u32x4 w; w.x = cvt_pk_bf16(y0[0], y0[1]); w.y = cvt_pk_bf16(y0[2], y0[3]); w.z = cvt_pk_bf16(y1[0], y1[1]); w.w = cvt_pk_bf16(y1[2], y1[3]);
                *(u32x4*)(X + (size_t)row * D + col) = w;
                const float* ap = adav + vi * 6144 + col;
                const f32x4 sh0 = *(const f32x4*)(ap), sh1 = *(const f32x4*)(ap + 4), sc0 = *(const f32x4*)(ap + 1024), sc1 = *(const f32x4*)(ap + 1028);
                const f32x4 h0 = y0 * (sc0 + 1.0f) + sh0, h1 = y1 * (sc1 + 1.0f) + sh1;
                u32x4 hw; hw.x = cvt_pk_bf16(h0[0], h0[1]); hw.y = cvt_pk_bf16(h0[2], h0[3]); hw.z = cvt_pk_bf16(h1[0], h1[1]); hw.w = cvt_pk_bf16(h1[2], h1[3]);
                *(u32x4*)(H + (size_t)row * D + col) = hw; }
        }
    }
}


template <bool FINAL>
__device__ __forceinline__ void ln_rows4(const Args& a, const float* lng, const float* lnb, float* xout, const float* adav, int rowbase, const float* bpf, const float* bsf) {
    const int lane = opaque_tid() & 63;
    const bf16_t* P0 = (const bf16_t*)(a.ws + WS_P0); const bf16_t* P1 = (const bf16_t*)(a.ws + WS_P1);
    bf16_t* H = (bf16_t*)(a.ws + WS_H); bf16_t* X = (bf16_t*)(a.ws + WS_X);
    constexpr int RB = 4;
    float v[RB][16]; float mean[RB], rstd[RB];
    const int vi = (rowbase < NPTOK) ? 0 : 1 + ((rowbase - NPTOK) >> 10);
    f32x4 pg[2][2], pb[2][2], psh[2][2], psc[2][2];
#pragma unroll
    for (int j = 0; j < 2; ++j) { const int col = 8 * lane + 512 * j;
        pg[j][0] = *(const f32x4*)(lng + col); pg[j][1] = *(const f32x4*)(lng + col + 4); pb[j][0] = *(const f32x4*)(lnb + col); pb[j][1] = *(const f32x4*)(lnb + col + 4);
        if (!FINAL) { const float* ap = adav + vi * 6144 + col; psh[j][0] = *(const f32x4*)(ap); psh[j][1] = *(const f32x4*)(ap + 4); psc[j][0] = *(const f32x4*)(ap + 1024); psc[j][1] = *(const f32x4*)(ap + 1028); } }
#pragma unroll
    for (int rr = 0; rr < RB; ++rr) { const int row = rowbase + rr;
#pragma unroll
        for (int j = 0; j < 2; ++j) { const int col = 8 * lane + 512 * j;
            const u32x4 p = *(const u32x4*)(P0 + (size_t)row * D + col), q = *(const u32x4*)(P1 + (size_t)row * D + col);
            v[rr][8 * j + 0] = bflo(p.x) + bflo(q.x); v[rr][8 * j + 1] = bfhi(p.x) + bfhi(q.x); v[rr][8 * j + 2] = bflo(p.y) + bflo(q.y); v[rr][8 * j + 3] = bfhi(p.y) + bfhi(q.y);
            v[rr][8 * j + 4] = bflo(p.z) + bflo(q.z); v[rr][8 * j + 5] = bfhi(p.z) + bfhi(q.z); v[rr][8 * j + 6] = bflo(p.w) + bflo(q.w); v[rr][8 * j + 7] = bfhi(p.w) + bfhi(q.w);
            if (bpf) { const float* br = ((row < NPTOK) ? bpf + (size_t)row * D : bsf + (size_t)(row - NPTOK) * D) + col; const f32x4 b0 = *(const f32x4*)br, b1 = *(const f32x4*)(br + 4);
#pragma unroll
                for (int e = 0; e < 4; ++e) { v[rr][8 * j + e] += ALPHA_C * b0[e]; v[rr][8 * j + 4 + e] += ALPHA_C * b1[e]; } }
            else { const u32x4 xb = *(const u32x4*)(X + (size_t)row * D + col);
                v[rr][8 * j + 0] += ALPHA_C * bflo(xb.x); v[rr][8 * j + 1] += ALPHA_C * bfhi(xb.x); v[rr][8 * j + 2] += ALPHA_C * bflo(xb.y); v[rr][8 * j + 3] += ALPHA_C * bfhi(xb.y);
                v[rr][8 * j + 4] += ALPHA_C * bflo(xb.z); v[rr][8 * j + 5] += ALPHA_C * bfhi(xb.z); v[rr][8 * j + 6] += ALPHA_C * bflo(xb.w); v[rr][8 * j + 7] += ALPHA_C * bfhi(xb.w); } } }
#pragma unroll
    for (int rr = 0; rr < RB; ++rr) { float s = 0.f;
#pragma unroll
        for (int e = 0; e < 16; ++e) s += v[rr][e];
        mean[rr] = s; }
#pragma unroll
    for (int o = 1; o < 64; o <<= 1)
#pragma unroll
        for (int rr = 0; rr < RB; ++rr) mean[rr] += __shfl_xor(mean[rr], o);
#pragma unroll
    for (int rr = 0; rr < RB; ++rr) { mean[rr] *= (1.0f / D); float s2 = 0.f;
#pragma unroll
        for (int e = 0; e < 16; ++e) { v[rr][e] -= mean[rr]; s2 += v[rr][e] * v[rr][e]; }
        rstd[rr] = s2; }
#pragma unroll
    for (int o = 1; o < 64; o <<= 1)
#pragma unroll
        for (int rr = 0; rr < RB; ++rr) rstd[rr] += __shfl_xor(rstd[rr], o);
#pragma unroll
    for (int rr = 0; rr < RB; ++rr) { const int row = rowbase + rr;
        const float rs = 1.0f / sqrtf(rstd[rr] * (1.0f / D) + LN_EPS_C);
#pragma unroll
        for (int j = 0; j < 2; ++j) { const int col = 8 * lane + 512 * j;
            const f32x4 g0 = pg[j][0], g1 = pg[j][1], b0 = pb[j][0], b1 = pb[j][1];
            f32x4 y0, y1;
#pragma unroll
            for (int e = 0; e < 4; ++e) { y0[e] = v[rr][8 * j + e] * rs * g0[e] + b0[e]; y1[e] = v[rr][8 * j + 4 + e] * rs * g1[e] + b1[e]; }
            if (FINAL) { *(f32x4*)(xout + (size_t)row * D + col) = y0; *(f32x4*)(xout + (size_t)row * D + col + 4) = y1; }
            else {
                u32x4 w; w.x = cvt_pk_bf16(y0[0], y0[1]); w.y = cvt_pk_bf16(y0[2], y0[3]); w.z = cvt_pk_bf16(y1[0], y1[1]); w.w = cvt_pk_bf16(y1[2], y1[3]);
                *(u32x4*)(X + (size_t)row * D + col) = w;
                const f32x4 sh0 = psh[j][0], sh1 = psh[j][1], sc0 = psc[j][0], sc1 = psc[j][1];
                const f32x4 h0 = y0 * (sc0 + 1.0f) + sh0, h1 = y1 * (sc1 + 1.0f) + sh1;
                u32x4 hw; hw.x = cvt_pk_bf16(h0[0], h0[1]); hw.y = cvt_pk_bf16(h0[2], h0[3]); hw.z = cvt_pk_bf16(h1[0], h1[1]); hw.w = cvt_pk_bf16(h1[2], h1[3]);
                *(u32x4*)(H + (size_t)row * D + col) = hw; }
        }
    }
}

__device__ __forceinline__ void conv3_chunk(const bf16_t* zrow, int s0, int L, float w0, float w1, float w2, float bb, float (&o)[8]) {
    const u32x4 q = *(const u32x4*)(zrow + s0);
    float z[10];
    z[1] = bflo(q.x); z[2] = bfhi(q.x); z[3] = bflo(q.y); z[4] = bfhi(q.y); z[5] = bflo(q.z); z[6] = bfhi(q.z); z[7] = bflo(q.w); z[8] = bfhi(q.w);
    z[0] = (s0 > 0) ? bf2f(zrow[s0 - 1]) : 0.f; z[9] = (s0 + 8 < L) ? bf2f(zrow[s0 + 8]) : 0.f;
#pragma unroll
    for (int e = 0; e < 8; ++e) o[e] = z[e] * w0 + z[e + 1] * w1 + z[e + 2] * w2 + bb;
}
__device__ __forceinline__ void conv3_regs(const u32x4 q, bf16_t prev, bf16_t next, float w0, float w1, float w2, float bb, float (&o)[8]) {
    float z[10];
    z[0] = bf2f(prev); z[1] = bflo(q.x); z[2] = bfhi(q.x); z[3] = bflo(q.y); z[4] = bfhi(q.y); z[5] = bflo(q.z); z[6] = bfhi(q.z); z[7] = bflo(q.w); z[8] = bfhi(q.w); z[9] = bf2f(next);
#pragma unroll
    for (int e = 0; e < 8; ++e) o[e] = z[e] * w0 + z[e + 1] * w1 + z[e + 2] * w2 + bb;
}
template <int L, int NBH>
__device__ __forceinline__ void hyena_item(const Args& a, LAS unsigned char* lds, int d0, int tokbase) {
    constexpr int nA = L / 32, BPT = 32 / nA, NT = NBH * nA / 32, NTOKI = NBH * L;
    static_assert(NT == 2 && NTOKI == 2048, "half-item geometry");
    const int tid = opaque_tid(), lane = tid & 63, wave = tid >> 6;
    const int d = d0 + wave;
    const bf16_t* zT = (const bf16_t*)(a.ws + WS_BIG);
    const bf16_t* R = (const bf16_t*)(a.ws + (L == 256 ? WS_RF256 : WS_RF1024)) + (size_t)d * 2 * L;
    LAS unsigned char* Fr = lds + wave * HY_WSTR;
    LAS unsigned char* Vr = Fr + 8192;
    LAS unsigned* cp = (LAS unsigned*)Fr;
    const float* sw = a.in[15]; const float* sb = a.in[16];
    LAS unsigned char* Xr = Fr + 13312;
    for (int hr1_ = 0; hr1_ <= (int)(HYREP & 1u); ++hr1_) {
    { const u32x4* rd4 = (const u32x4*)R; const unsigned* rd = (const unsigned*)R;
      u32x4 fx[L / 256]; unsigned fy[L / 256];
#pragma unroll
      for (int it = 0; it < L / 256; ++it) { const int q4 = lane + 64 * it; fx[it] = rd4[q4]; fy[it] = (4 * q4 + 4 < L) ? rd[4 * q4 + 4] : 0u; }
#pragma unroll
      for (int it = 0; it < L / 256; ++it) { const int q = 4 * (lane + 64 * it); const u32x4 x = fx[it];
          *(LAS u32x4*)(cp + q) = x;
          u32x4 y; y.x = (x.x >> 16) | (x.y << 16); y.y = (x.y >> 16) | (x.z << 16); y.z = (x.z >> 16) | (x.w << 16); y.w = (x.w >> 16) | (fy[it] << 16);
          *(LAS u32x4*)(cp + L + q) = y; } }
    { const float v0 = sw[2048 + d], v1 = sw[3072 + 2048 + d], v2 = sw[6144 + 2048 + d], vb = sb[2048 + d];
      const float x0 = sw[1024 + d], x1 = sw[3072 + 1024 + d], x2 = sw[6144 + 1024 + d], xb = sb[1024 + d];
      const float o0 = sw[d], o1 = sw[3072 + d], o2 = sw[6144 + d], ob = sb[d];
      const bf16_t* zv = zT + (size_t)(2048 + d) * NTOK + tokbase; const bf16_t* zx = zT + (size_t)(1024 + d) * NTOK + tokbase; const bf16_t* zo = zT + (size_t)d * NTOK + tokbase;
      constexpr int NI = NTOKI / 8 / 64;
      u32x4 rv[NI], rx[NI], ro[NI]; bf16_t pv[NI], nv[NI], px[NI], nx[NI], po[NI], no[NI];
#pragma unroll
      for (int it = 0; it < NI; ++it) { const int idx = lane + 64 * it; const int t0 = idx * 8, s0 = t0 % L;
          rv[it] = *(const u32x4*)(zv + t0); rx[it] = *(const u32x4*)(zx + t0); ro[it] = *(const u32x4*)(zo + t0);
          const bool hp = s0 > 0, hn = s0 + 8 < L;
          pv[it] = hp ? zv[t0 - 1] : (bf16_t)0; nv[it] = hn ? zv[t0 + 8] : (bf16_t)0;
          px[it] = hp ? zx[t0 - 1] : (bf16_t)0; nx[it] = hn ? zx[t0 + 8] : (bf16_t)0;
          po[it] = hp ? zo[t0 - 1] : (bf16_t)0; no[it] = hn ? zo[t0 + 8] : (bf16_t)0; }
#pragma unroll
      for (int it = 0; it < NI; ++it) { const int idx = lane + 64 * it; const int t0 = idx * 8;
          float cv[8], cx[8], co[8];
          conv3_regs(rv[it], pv[it], nv[it], v0, v1, v2, vb, cv); conv3_regs(rx[it], px[it], nx[it], x0, x1, x2, xb, cx); conv3_regs(ro[it], po[it], no[it], o0, o1, o2, ob, co);
          u32x4 w; w.x = cvt_pk_bf16(cv[0] * cx[0], cv[1] * cx[1]); w.y = cvt_pk_bf16(cv[2] * cx[2], cv[3] * cx[3]); w.z = cvt_pk_bf16(cv[4] * cx[4], cv[5] * cx[5]); w.w = cvt_pk_bf16(cv[6] * cx[6], cv[7] * cx[7]);
          *(LAS u32x4*)(Vr + (t0 >> 5) * 80 + (t0 & 31) * 2) = w;
          u32x4 wo; wo.x = cvt_pk_bf16(co[0], co[1]); wo.y = cvt_pk_bf16(co[2], co[3]); wo.z = cvt_pk_bf16(co[4], co[5]); wo.w = cvt_pk_bf16(co[6], co[7]);
          *(LAS u32x4*)(Xr + (size_t)t0 * 2) = wo; } }
    __syncthreads(); }
    __syncthreads();
    f32x16 acc[NT];
#pragma unroll
    for (int q = 0; q < NT; ++q)
#pragma unroll
        for (int e = 0; e < 16; ++e) acc[q][e] = 0.f;
    for (int hr2_ = 0; hr2_ <= (int)((HYREP >> 1) & 1u); ++hr2_) {
    if (hr2_ == 1) { _Pragma("unroll") for (int q = 0; q < NT; ++q) _Pragma("unroll") for (int e = 0; e < 16; ++e) acc[q][e] *= 0.5f; }
    {
        const int i = lane & 31, h = lane >> 5, p = 1 - (i & 1);
        const int n = lane & 31, aidx = n % nA, bsub = n / nA;
        LAS const unsigned* cpp = cp + p * L;
        LAS const unsigned char* zero16 = lds + HY_ZERO;
        LAS const unsigned char* vlane = Vr + bsub * nA * 80 + 16 * h;
        const int mbase = (L - 1) - i + 8 * h;
        LAS const unsigned* ap = cpp + (mbase >> 1) + 16 * (nA - 1);
        int ab = aidx + (nA - 1);
        LAS const unsigned char* vr = vlane + ab * 80;
#pragma unroll 1
        for (int it = 0; it < 2 * nA - 1; ++it) {
            const bool ok = (ab >= 0) && (ab < nA);
            LAS const unsigned char* vrow = ok ? vr : zero16;
            const int vstep = ok ? BPT * nA * 80 : 0, jstep = ok ? 32 : 0;
            u32x4 af0, af1; af0.x = ap[0]; af0.y = ap[1]; af0.z = ap[2]; af0.w = ap[3]; af1.x = ap[8]; af1.y = ap[9]; af1.z = ap[10]; af1.w = ap[11];
            u32x4 bf[NT][2];
#pragma unroll
            for (int q = 0; q < NT; ++q) { bf[q][0] = *(LAS const u32x4*)(vrow + q * vstep); bf[q][1] = *(LAS const u32x4*)(vrow + q * vstep + jstep); }
#pragma unroll
            for (int q = 0; q < NT; ++q) {
                acc[q] = __builtin_amdgcn_mfma_f32_32x32x16_bf16(__builtin_bit_cast(bf16x8, af0), __builtin_bit_cast(bf16x8, bf[q][0]), acc[q], 0, 0, 0);
                acc[q] = __builtin_amdgcn_mfma_f32_32x32x16_bf16(__builtin_bit_cast(bf16x8, af1), __builtin_bit_cast(bf16x8, bf[q][1]), acc[q], 0, 0, 0); }
            ap -= 16; ab -= 1; vr -= 80;
        }
    }
    }
    if ((HYREP >> 1) & 1u) { _Pragma("unroll") for (int q = 0; q < NT; ++q) _Pragma("unroll") for (int e = 0; e < 16; ++e) acc[q][e] *= (2.0f / 3.0f); }
    __syncthreads();
    { const int h = lane >> 5, n = lane & 31, aidx = n % nA, bsub = n / nA;
#pragma unroll
      for (int q = 0; q < NT; ++q) { const int b = q * BPT + bsub;
#pragma unroll
          for (int rg = 0; rg < 4; ++rg) { const int t = 32 * aidx + 8 * rg + 4 * h; const int off = (b * L + t) * 2;
              const u32x2 xc = *(LAS const u32x2*)(Xr + off);
              u32x2 w; w.x = cvt_pk_bf16(acc[q][4 * rg] * bflo(xc.x), acc[q][4 * rg + 1] * bfhi(xc.x)); w.y = cvt_pk_bf16(acc[q][4 * rg + 2] * bflo(xc.y), acc[q][4 * rg + 3] * bfhi(xc.y));
              *(LAS u32x2*)(Vr + ((b * L + t) >> 5) * 80 + (t & 31) * 2) = w; } } }
    __syncthreads();
    for (int hr3_ = 0; hr3_ <= (int)((HYREP >> 2) & 1u); ++hr3_)
    { bf16_t* Y = (bf16_t*)(a.ws + WS_Y);
#pragma unroll
      for (int it = 0; it < NTOKI / NTHR; ++it) { const int tok = tid + it * NTHR; unsigned short e[8];
#pragma unroll
          for (int w = 0; w < 8; ++w) e[w] = *(LAS const unsigned short*)(lds + w * HY_WSTR + 8192 + (tok >> 5) * 80 + (tok & 31) * 2);
          u32x4 o; o.x = e[0] | ((unsigned)e[1] << 16); o.y = e[2] | ((unsigned)e[3] << 16); o.z = e[4] | ((unsigned)e[5] << 16); o.w = e[6] | ((unsigned)e[7] << 16);
          *(u32x4*)(Y + (size_t)(tokbase + tok) * D + d0) = o; } }
    __syncthreads();
}

constexpr int AT_KP = 144, AT_VP = 528;
constexpr int AT_K_OFF = 2048, AT_V_OFF = AT_K_OFF + 256 * AT_KP;
constexpr int AT_LVP = 912;
constexpr int AT_LK_OFF = 2048, AT_LV_OFF = 65536;
__device__ __forceinline__ void attn_stage_kv(LAS unsigned char* lds, const char* ksrc, const char* vsrc, int vpitch) {
    const int tid = opaque_tid();
    u32x4 kv[4], vv[4];
#pragma unroll
    for (int k = 0; k < 4; ++k) { const int p = tid + NTHR * k; kv[k] = *(const u32x4*)(ksrc + (size_t)p * 16); vv[k] = *(const u32x4*)(vsrc + (size_t)(p >> 5) * vpitch + (p & 31) * 16); }
#pragma unroll
    for (int k = 0; k < 4; ++k) { const int p = tid + NTHR * k;
        *(LAS u32x4*)(lds + AT_K_OFF + (p >> 3) * AT_KP + (p & 7) * 16) = kv[k];
        *(LAS u32x4*)(lds + AT_V_OFF + (p >> 5) * AT_VP + (p & 31) * 16) = vv[k]; }
}
template <bool FROM_LDS, bool MASK>
__device__ __forceinline__ void attn_chunk(f32x4 (&O)[4], float& m_run, float& sum, const bf16x8 q0, const bf16x8 q1,
                                           const char* kb, const char* vb, int kseg, int vseg, int vrow16, unsigned k0o, unsigned k1o, unsigned vo,
                                           LAS const unsigned char* lk, LAS const unsigned char* lv,
                                           LAS const float* rb, int band0, int g, int qc, int win0) {
    f32x4 S[4][2];
    bf16x8 Vf[4][4];
#pragma unroll
    for (int s4 = 0; s4 < 2; ++s4)
#pragma unroll
        for (int db = 0; db < 4; ++db) {
            if (!FROM_LDS) Vf[s4][db] = *(const bf16x8*)(vb + (size_t)s4 * vseg + (size_t)db * vrow16 + vo); }
#pragma unroll
    for (int s4 = 0; s4 < 4; ++s4) {
        bf16x8 a00, a01, a10, a11;
        if (FROM_LDS) { LAS const unsigned char* ks = lk + s4 * kseg;
            a00 = *(LAS const bf16x8*)(ks); a01 = *(LAS const bf16x8*)(ks + 64); a10 = *(LAS const bf16x8*)(ks + 4 * AT_KP); a11 = *(LAS const bf16x8*)(ks + 4 * AT_KP + 64); }
        else { const char* ks = kb + (size_t)s4 * kseg;
            a00 = *(const bf16x8*)(ks + k0o); a01 = *(const bf16x8*)(ks + k0o + 64); a10 = *(const bf16x8*)(ks + k1o); a11 = *(const bf16x8*)(ks + k1o + 64); }
        f32x4 c0 = (f32x4){0.f, 0.f, 0.f, 0.f}, c1 = (f32x4){0.f, 0.f, 0.f, 0.f};
        c0 = __builtin_amdgcn_mfma_f32_16x16x32_bf16(a00, q0, c0, 0, 0, 0);
        c0 = __builtin_amdgcn_mfma_f32_16x16x32_bf16(a01, q1, c0, 0, 0, 0);
        c1 = __builtin_amdgcn_mfma_f32_16x16x32_bf16(a10, q0, c1, 0, 0, 0);
        c1 = __builtin_amdgcn_mfma_f32_16x16x32_bf16(a11, q1, c1, 0, 0, 0);
        S[s4][0] = c0; S[s4][1] = c1;
        if (FROM_LDS) asm volatile("" ::: "memory");
    }
    if (!FROM_LDS) {
        asm volatile("" ::: "memory");
#pragma unroll
        for (int s4 = 2; s4 < 4; ++s4)
#pragma unroll
            for (int db = 0; db < 4; ++db) Vf[s4][db] = *(const bf16x8*)(vb + (size_t)s4 * vseg + (size_t)db * vrow16 + vo);
    }
    if (MASK) {
#pragma unroll
        for (int s4 = 0; s4 < 4; ++s4) { LAS const float* rr = rb + s4 * 31;
#pragma unroll
            for (int t = 0; t < 2; ++t)
#pragma unroll
                for (int e = 0; e < 4; ++e) { const int kc = band0 + 8 * g + 4 * t + e; const bool ok = (kc >= win0) && (kc < win0 + 16);
                    const int dc = min(max(kc - qc + 15, 0), 30);
                    S[s4][t][e] = ok ? S[s4][t][e] + rr[dc] : -INFINITY; } }
    }
    float mx = -INFINITY;
#pragma unroll
    for (int s4 = 0; s4 < 4; ++s4)
#pragma unroll
        for (int t = 0; t < 2; ++t)
#pragma unroll
            for (int e = 0; e < 4; ++e) mx = fmaxf(mx, S[s4][t][e]);
    mx = fmaxf(mx, __shfl_xor(mx, 16)); mx = fmaxf(mx, __shfl_xor(mx, 32));
    const float mnew = fmaxf(m_run, mx);
    const float scl = __builtin_amdgcn_exp2f((m_run - mnew) * 1.4426950408889634f);
    m_run = mnew;
    float ps = 0.f;
#pragma unroll
    for (int s4 = 0; s4 < 4; ++s4)
#pragma unroll
        for (int t = 0; t < 2; ++t)
#pragma unroll
            for (int e = 0; e < 4; ++e) { const float p = __builtin_amdgcn_exp2f((S[s4][t][e] - mnew) * 1.4426950408889634f); S[s4][t][e] = p; ps += p; }
    ps += __shfl_xor(ps, 16); ps += __shfl_xor(ps, 32);
    sum = sum * scl + ps;
#pragma unroll
    for (int db = 0; db < 4; ++db) O[db] = O[db] * scl;
#pragma unroll
    for (int s4 = 0; s4 < 4; ++s4) {
        u32x4 pw; pw.x = cvt_pk_bf16(S[s4][0][0], S[s4][0][1]); pw.y = cvt_pk_bf16(S[s4][0][2], S[s4][0][3]); pw.z = cvt_pk_bf16(S[s4][1][0], S[s4][1][1]); pw.w = cvt_pk_bf16(S[s4][1][2], S[s4][1][3]);
        const bf16x8 pf = __builtin_bit_cast(bf16x8, pw);
#pragma unroll
        for (int db = 0; db < 4; ++db) { if (FROM_LDS) Vf[s4][db] = *(LAS const bf16x8*)(lv + db * vrow16 + s4 * vseg);
            O[db] = __builtin_amdgcn_mfma_f32_16x16x32_bf16(Vf[s4][db], pf, O[db], 0, 0, 0); }
        if (FROM_LDS) asm volatile("" ::: "memory");
    }
    asm volatile("" ::: "memory");
}

__device__ __forceinline__ void attn_ctx_tile(const Args& a, LAS unsigned char* lds, int b, int h, int qt, int lane) {
    const char* BB = (const char*)(a.ws + WS_BIG);
    bf16_t* Y = (bf16_t*)(a.ws + WS_Y);
    const int ql = lane & 15, g = lane >> 4;
    const int qtok0 = b * LP + qt * 16;
    const char* qb = BB + (BQ_OFF + (size_t)qtok0 * D + h * HD) * 2;
    const int ci0 = 8 * (ql >> 2) + (ql & 3);
    const bf16x8 q0 = *(const bf16x8*)(qb + (unsigned)((ql * D + 8 * g) * 2)), q1 = *(const bf16x8*)(qb + (unsigned)((ql * D + 8 * g) * 2) + 64);
    LAS const unsigned char* lk = lds + AT_K_OFF + ci0 * AT_KP + 16 * g;
    LAS const unsigned char* lv = lds + AT_V_OFF + ql * AT_VP + 16 * g;
    float m_run = -INFINITY, sum = 0.f;
    f32x4 O[4];
#pragma unroll
    for (int db = 0; db < 4; ++db) O[db] = (f32x4){0.f, 0.f, 0.f, 0.f};
#pragma unroll 1
    for (int c = 0; c < 2; ++c)
        attn_chunk<true, false>(O, m_run, sum, q0, q1, nullptr, nullptr, 32 * AT_KP, 64, 16 * AT_VP, 0u, 0u, 0u, lk + c * 128 * AT_KP, lv + c * 256, (LAS const float*)lds, 0, g, 0, 0);
    const float inv = 1.0f / sum;
    bf16_t* op = Y + (size_t)(qtok0 + ql) * D + h * HD + 4 * g;
#pragma unroll
    for (int db = 0; db < 4; ++db) { u32x2 w; w.x = cvt_pk_bf16(O[db][0] * inv, O[db][1] * inv); w.y = cvt_pk_bf16(O[db][2] * inv, O[db][3] * inv); *(u32x2*)(op + db * 16) = w; }
}

__device__ __forceinline__ void attn_stage_local(const Args& a, LAS unsigned char* lds, int b, int h, int rowmin, int nrows, int cbase) {
    const int tid = opaque_tid();
    const char* BB = (const char*)(a.ws + WS_BIG);
    const char* ks = BB + (BK_OFF + (size_t)NPTOK * D + ((size_t)(b * NH + h) * LSQ + rowmin * 64 + cbase) * HD) * 2;
    const char* vs = BB + (BVS_OFF + ((size_t)(b * NH + h) * HD) * VPS + rowmin * 64 + cbase) * 2;
    const int total = nrows * 320, n5 = nrows * 5;
    { u32x4 kv[7];
#pragma unroll
      for (int k = 0; k < 7; ++k) { const int p = tid + NTHR * k;
          if (p < total) { const int kr = p / 320, rem = p - kr * 320; kv[k] = *(const u32x4*)(ks + (size_t)kr * (64 * 128) + rem * 16); } }
#pragma unroll
      for (int k = 0; k < 7; ++k) { const int p = tid + NTHR * k;
          if (p < total) { const int kr = p / 320, rem = p - kr * 320, key = rem >> 3, c16 = rem & 7; *(LAS u32x4*)(lds + AT_LK_OFF + (kr * 40 + key) * AT_KP + c16 * 16) = kv[k]; } } }
    asm volatile("" ::: "memory");
    { u32x4 vv[7];
#pragma unroll
      for (int k = 0; k < 7; ++k) { const int p = tid + NTHR * k;
          if (p < total) { const int d = p / n5, rm = p - d * n5, kr2 = rm / 5, c16 = rm - kr2 * 5; vv[k] = *(const u32x4*)(vs + (size_t)d * (VPS * 2) + kr2 * 128 + c16 * 16); } }
#pragma unroll
      for (int k = 0; k < 7; ++k) { const int p = tid + NTHR * k;
          if (p < total) { const int d = p / n5, rm = p - d * n5, kr2 = rm / 5, c16v = rm - kr2 * 5; *(LAS u32x4*)(lds + AT_LV_OFF + d * AT_LVP + kr2 * 80 + c16v * 16) = vv[k]; } } }
}

__device__ __forceinline__ void attn_latent_unit(const Args& a, LAS unsigned char* lds, int b, int h, int i4, int lane, int wave) {
    const char* BB = (const char*)(a.ws + WS_BIG);
    bf16_t* Y = (bf16_t*)(a.ws + WS_Y);
    LAS float* rpbh = (LAS float*)lds;
    const int tid = opaque_tid();
    const int rowmin = min(max(4 * i4 - 4, 0), 8), rowmax = min(max(4 * i4 - 1, 0), 8) + 7, nrows = rowmax - rowmin + 1;
    const int r = 4 * i4 + (wave >> 1), row0 = min(max(r - 4, 0), 8);
    const int ql = lane & 15, g = lane >> 4, ci0 = 8 * (ql >> 2) + (ql & 3);
    f32x4 O[2][4]; float m_run[2], sum[2];
#pragma unroll
    for (int pr = 0; pr < 2; ++pr) {
        const int j = 2 * pr + (wave & 1), cbase = 24 * pr, band0 = min(max(16 * j - 8, 0), 32), off = band0 - cbase;
        __syncthreads();
        if (pr == 0) { for (int i = tid; i < 465; i += NTHR) rpbh[i] = a.in[27][h * 465 + i]; }
        attn_stage_local(a, lds, b, h, rowmin, nrows, cbase);
        __syncthreads();
        const int qtok0 = NPTOK + b * LSQ + r * 64 + j * 16;
        const char* qb = BB + (BQ_OFF + (size_t)qtok0 * D + h * HD) * 2;
        const bf16x8 q0 = *(const bf16x8*)(qb + (unsigned)((ql * D + 8 * g) * 2)), q1 = *(const bf16x8*)(qb + (unsigned)((ql * D + 8 * g) * 2) + 64);
        m_run[pr] = -INFINITY; sum[pr] = 0.f;
#pragma unroll
        for (int db = 0; db < 4; ++db) O[pr][db] = (f32x4){0.f, 0.f, 0.f, 0.f};
        const int kl0 = (row0 - rowmin) * 40 + off;
        LAS const unsigned char* lk = lds + AT_LK_OFF + (kl0 + ci0) * AT_KP + 16 * g;
        LAS const unsigned char* lv = lds + AT_LV_OFF + ql * AT_LVP + (kl0 + 8 * g) * 2;
        const int qc = 16 * j + ql, win0 = min(max(qc - 8, 0), 48);
        LAS const float* rb = rpbh + (row0 - r + 7) * 31;
#pragma unroll 1
        for (int c = 0; c < 2; ++c)
            attn_chunk<true, true>(O[pr], m_run[pr], sum[pr], q0, q1, nullptr, nullptr, 40 * AT_KP, 80, 16 * AT_LVP, 0u, 0u, 0u,
                                   lk + c * 4 * 40 * AT_KP, lv + c * 4 * 80, rb + c * 4 * 31, band0, g, qc, win0);
    }
    __syncthreads();
    attn_stage_kv(lds, (const char*)(a.ws + WS_CK) + (size_t)(b * NH + h) * 256 * HD * 2, (const char*)(a.ws + WS_CVT) + (size_t)(b * NH + h) * HD * CVP * 2, CVP * 2);
    __syncthreads();
    {
        LAS const unsigned char* lk = lds + AT_K_OFF + ci0 * AT_KP + 16 * g;
        LAS const unsigned char* lv = lds + AT_V_OFF + ql * AT_VP + 16 * g;
#pragma unroll
        for (int pr = 0; pr < 2; ++pr) {
            const int j = 2 * pr + (wave & 1);
            const int qtok0 = NPTOK + b * LSQ + r * 64 + j * 16;
            const char* qb = BB + (BQ_OFF + (size_t)qtok0 * D + h * HD) * 2;
            const bf16x8 q0 = *(const bf16x8*)(qb + (unsigned)((ql * D + 8 * g) * 2)), q1 = *(const bf16x8*)(qb + (unsigned)((ql * D + 8 * g) * 2) + 64);
#pragma unroll 1
            for (int c = 0; c < 2; ++c)
                attn_chunk<true, false>(O[pr], m_run[pr], sum[pr], q0, q1, nullptr, nullptr, 32 * AT_KP, 64, 16 * AT_VP, 0u, 0u, 0u, lk + c * 128 * AT_KP, lv + c * 256, rpbh, 0, g, 0, 0);
            const float inv = 1.0f / sum[pr];
            bf16_t* op = Y + (size_t)(qtok0 + ql) * D + h * HD + 4 * g;
#pragma unroll
            for (int db = 0; db < 4; ++db) { u32x2 w; w.x = cvt_pk_bf16(O[pr][db][0] * inv, O[pr][db][1] * inv); w.y = cvt_pk_bf16(O[pr][db][2] * inv, O[pr][db][3] * inv); *(u32x2*)(op + db * 16) = w; }
        }
    }
}

__device__ __forceinline__ void attn_phase(const Args& a, LAS unsigned char* lds) {
    const int tid = opaque_tid(), lane = tid & 63, wave = __builtin_amdgcn_readfirstlane(tid >> 6), bx = blockIdx.x, G = gridDim.x;
    const int vcu = (G % 8 == 0) ? (bx % 8) * (G / 8) + bx / 8 : bx;
    const char* BB = (const char*)(a.ws + WS_BIG);
    for (int u = vcu; u < 256; u += G) { const int bh = u >> 2; attn_latent_unit(a, lds, bh >> 4, bh & 15, u & 3, lane, wave); }
    for (int u = vcu; u < 256; u += G) {
        const int b = u >> 4, h = u & 15;
        __syncthreads();
        attn_stage_kv(lds, BB + (BK_OFF + (size_t)u * LP * HD) * 2, BB + (BV_OFF + (size_t)u * HD * VPP) * 2, VPP * 2);
        __syncthreads();
#pragma unroll 1
        for (int tt = 0; tt < 2; ++tt) attn_ctx_tile(a, lds, b, h, 2 * wave + tt, lane);
    }
    __syncthreads();
}

__device__ __forceinline__ void cache_convert(const Args& a, int slot, int nslots) {
    const int tid = opaque_tid();
    const int gt = slot * NTHR + tid, NGT = nslots * NTHR;
    for (int i = gt; i < 131072; i += NGT) {
        const f32x4 x0 = *(const f32x4*)(a.in[2] + (size_t)i * 8), x1 = *(const f32x4*)(a.in[2] + (size_t)i * 8 + 4);
        u32x4 o; o.x = cvt_pk_bf16(x0[0], x0[1]); o.y = cvt_pk_bf16(x0[2], x0[3]); o.z = cvt_pk_bf16(x1[0], x1[1]); o.w = cvt_pk_bf16(x1[2], x1[3]);
        *(u32x4*)((bf16_t*)(a.ws + WS_CK) + (size_t)i * 8) = o;
        const int d = i & 63, sg = (i >> 6) & 31, bh = i >> 11;
        const float* src = a.in[3] + ((size_t)bh * 256 + 8 * sg) * 64 + d;
        u32x4 p; p.x = cvt_pk_bf16(src[0], src[64]); p.y = cvt_pk_bf16(src[128], src[192]); p.z = cvt_pk_bf16(src[256], src[320]); p.w = cvt_pk_bf16(src[384], src[448]);
        *(u32x4*)((bf16_t*)(a.ws + WS_CVT) + ((size_t)bh * 64 + d) * CVP + 8 * sg) = p;
    }
}

#ifndef PHASES
#define PHASES 0xFFFFFFFFu
#endif
#define PH(k) ((PHASES >> (k)) & 1u)
#ifndef REP
#define REP 0x0u
#endif
#ifndef HYREP
#define HYREP 0x0u
#endif
#ifndef XSYNC
#define XSYNC 0
#endif
#define RP(k) for (int rep_ = 0; rep_ <= (int)((REP >> (k)) & 1u); ++rep_)
__global__ void __launch_bounds__(NTHR, 2) fwd_megakernel(Args a) {
    extern __shared__ __attribute__((aligned(16))) unsigned char lds_raw[];
    LAS unsigned char* lds = (LAS unsigned char*)lds_raw;
    cg::grid_group grid = cg::this_grid();
    if (a.ws == nullptr) grid.sync();
    if (opaque_tid() < 64) ((volatile LAS unsigned*)(lds + LDS_CTL))[opaque_tid()] = 0u;
    __syncthreads();
    const XcdBarrier xbar = xcd_barrier_post((unsigned*)(a.ws + WS_BAR), (volatile LAS unsigned*)(lds + LDS_CTL));
#define GSYNC() xcd_barrier(xbar)
#define LSYNC() do { if (xl_ok) xcd_local_barrier(xbar); else xcd_barrier(xbar); } while (0)
#define IDLE_DEFER(ntot, r0, r1, cid) do { const int rounds_ = ((ntot) + G - 1) / G, nidle_ = rounds_ * G - (ntot); \
    if (nidle_ > 0) { if (cid >= G - nidle_) deferred_transposes(a, lds, r0, r1, cid - (G - nidle_), nidle_); } else deferred_transposes(a, lds, r0, r1, cid, G); } while (0)
    const int G = gridDim.x, bx = blockIdx.x;
    unsigned char* ws = a.ws;
    const float* ada = (const float*)(ws + WS_ADA);
    bf16_t* H = (bf16_t*)(ws + WS_H); bf16_t* Yb = (bf16_t*)(ws + WS_Y);
    bf16_t* X = (bf16_t*)(ws + WS_X); bf16_t* P0 = (bf16_t*)(ws + WS_P0); bf16_t* P1 = (bf16_t*)(ws + WS_P1);
    bf16_t* BIG = (bf16_t*)(ws + WS_BIG);

    RP(0) { if (PH(0)) { p0_prep(a, lds); }
      GSYNC(); }
    const unsigned xl_ok = (unsigned)__builtin_amdgcn_readfirstlane((int)xbar.st[2]);
    const int vb = xl_ok ? __builtin_amdgcn_readfirstlane((int)(xbar.st[3] * 8u + xbar.x)) : bx;
    const int vbln = xl_ok ? vb : -1;

    RP(2) { if (PH(2)) { { pg8::Gemm g{(const bf16_t*)(ws + WS_WHYIN), H, 1024, 1024}; pg8::Order S; S.init(3072, NTOK, 1, G, bx);
      pg8::EpiBf16T E{BIG, NTOK}; pg8::gemm_phase(lds, g, S, E); }
      { const int nidle_c = 2 * G - 384; if (nidle_c > 0 && nidle_c <= G) { if (bx >= G - nidle_c) cache_convert(a, bx - (G - nidle_c), nidle_c); } else cache_convert(a, bx, G); }
      IDLE_DEFER(384, TR_S1_BEG, TR_S1_END, bx); }
      GSYNC(); }
    RP(3) { if (PH(3)) { { for (int it = bx; it < 256; it += G) { hyena_item<1024, 2>(a, lds, 8 * (it >> 1), NPTOK + 2048 * (it & 1)); hyena_item<256, 8>(a, lds, 8 * (it >> 1), 2048 * (it & 1)); } } }
      GSYNC(); }
    RP(4) { if (PH(4)) { { pg8::Gemm g{Yb, (const bf16_t*)(ws + WS_WHYOUT), 512, 1024}; pg8::Order S; S.init(NTOK, 1024, 2, G, vb);
      pg8::EpiRes<true> E{a.in[0], a.in[1], ada + 2048, P0, P1}; pg8::gemm_phase(lds, g, S, E); } }
      LSYNC(); }
    RP(5) { if (PH(5)) { ln_phase<false>(a, a.in[8], a.in[9], nullptr, ada + 3072, vbln, a.in[0], a.in[1]); }
      LSYNC(); }
    RP(6) { if (PH(6)) { { pg8::Gemm g{H, (const bf16_t*)(ws + WS_WFFIN), 1024, 1024}; pg8::Order S; S.init(NTOK, 5632, 1, G, vb);
      pg8::EpiSwiglu E{BIG}; pg8::gemm_phase(lds, g, S, E); }
      IDLE_DEFER(704, TR_S2_BEG, TR_S2_END, vb); }
      LSYNC(); }
    RP(7) { if (PH(7)) { { pg8::Gemm g{BIG, (const bf16_t*)(ws + WS_WFFOUT), 1408, DFF}; pg8::Order S; S.init(NTOK, 1024, 2, G, vb);
      pg8::EpiRes<false> E{X, X + (size_t)NPTOK * D, ada + 5120, P0, P1}; pg8::gemm_phase(lds, g, S, E); } }
      LSYNC(); }
    RP(8) { if (PH(8)) { ln_phase<false>(a, a.in[10], a.in[11], nullptr, ada + 5 * 6144, vbln);   }
      GSYNC(); }

    for (int xs_ = 0; xs_ < XSYNC; ++xs_) GSYNC();
    RP(9) { if (PH(9)) { { pg8::Gemm g{H, (const bf16_t*)(ws + WS_WQKV), 1024, 1024}; pg8::Order S; S.init(NTOK, 3072, 1, G, bx);
      pg8::EpiQKV E{BIG, a.out + (size_t)NTOK * D, a.out + (size_t)NTOK * D + (size_t)NPTOK * D}; pg8::gemm_phase(lds, g, S, E); }
      IDLE_DEFER(384, TR_S3_BEG, TR_S3_END, bx); }
      GSYNC(); }
    RP(10) { if (PH(10)) { attn_phase(a, lds); }
      GSYNC(); }
    RP(11) { if (PH(11)) { { pg8::Gemm g{Yb, (const bf16_t*)(ws + WS_WNAOUT), 512, 1024}; pg8::Order S; S.init(NTOK, 1024, 2, G, vb);
      pg8::EpiRes<false> E{X, X + (size_t)NPTOK * D, ada + 5 * 6144 + 2048, P0, P1}; pg8::gemm_phase(lds, g, S, E); } }
      LSYNC(); }
    RP(12) { if (PH(12)) { ln_phase<false>(a, a.in[8] + D, a.in[9] + D, nullptr, ada + 5 * 6144 + 3072, vbln); }
      LSYNC(); }
    RP(13) { if (PH(13)) { { pg8::Gemm g{H, (const bf16_t*)(ws + WS_WFFIN) + (size_t)5632 * 1024, 1024, 1024}; pg8::Order S; S.init(NTOK, 5632, 1, G, vb);
      pg8::EpiSwiglu E{BIG}; pg8::gemm_phase(lds, g, S, E); } }
      LSYNC(); }
    RP(14) { if (PH(14)) { { pg8::Gemm g{BIG, (const bf16_t*)(ws + WS_WFFOUT) + (size_t)1024 * DFF, 1408, DFF}; pg8::Order S; S.init(NTOK, 1024, 2, G, vb);
      pg8::EpiRes<false> E{X, X + (size_t)NPTOK * D, ada + 5 * 6144 + 5120, P0, P1}; pg8::gemm_phase(lds, g, S, E); } }
      LSYNC(); }
    RP(15) { if (PH(15)) { ln_phase<true>(a, a.in[10] + D, a.in[11] + D, a.out, ada, vbln); } }
}

extern "C" void kernel_launch(void* const* d_in, const int* in_sizes, int n_in, void* d_out, int out_size, void* d_ws, size_t ws_size, hipStream_t stream) {
    static int grid = 0;
    if (grid == 0) {
        if (n_in != 29 || ws_size < WS_END) { fprintf(stderr, "kernel_launch: unexpected n_in %d or ws_size %zu (need %zu)\n", n_in, ws_size, (size_t)WS_END); grid = -1; return; }
        int dev = 0, cus = 0, per_cu = 0;
        hipGetDevice(&dev);
        hipDeviceGetAttribute(&cus, hipDeviceAttributeMultiprocessorCount, dev);
        if (hipFuncSetAttribute((const void*)fwd_megakernel, hipFuncAttributeMaxDynamicSharedMemorySize, LDS_BYTES) != hipSuccess) { fprintf(stderr, "kernel_launch: hipFuncSetAttribute failed\n"); grid = -1; return; }
        if (hipOccupancyMaxActiveBlocksPerMultiprocessor(&per_cu, (const void*)fwd_megakernel, NTHR, LDS_BYTES) != hipSuccess || per_cu < 1) { fprintf(stderr, "kernel_launch: occupancy query says %d\n", per_cu); per_cu = 1; }
        (void)hipGetLastError();
        grid = cus;
        if (grid > 256) grid = 256;
    }
    if (grid < 0) return;
    if (hipMemsetAsync((char*)d_ws + WS_BAR, 0, XB_ALL_WORDS * 4, stream) != hipSuccess) { fprintf(stderr, "kernel_launch: memset failed\n"); return; }
    Args a{};
    for (int i = 0; i < 29; ++i) a.in[i] = (const float*)d_in[i];
    a.out = (float*)d_out; a.ws = (unsigned char*)d_ws;
    void* args[] = {&a};
    hipError_t e = hipLaunchCooperativeKernel((const void*)fwd_megakernel, dim3(grid), dim3(NTHR), args, LDS_BYTES, stream);
    if (e != hipSuccess) fprintf(stderr, "cooperative launch failed: %s (grid %d)\n", hipGetErrorString(e), grid);
}
```
